# Optimizing an MI355X kernel written in HIP

```python
import jax, jax.numpy as jnp
from jax import lax
import numpy as np

D_MODEL = 1024
BATCH = 2
SEQ = 8192
DEPTH = 2

W_A = D_MODEL
K_A = 3
W_B = D_MODEL
K_B = 31
W_C = D_MODEL
POOL_WINDOWS = (2, 4, 8, 16)
N_POOL_GROUPS = len(POOL_WINDOWS)
GC = W_C // N_POOL_GROUPS
N_BRANCH = 3
D_FF = 4 * D_MODEL
EPS = 1e-6
COLS_A = 3 * W_A
COLS_B = 2 * W_B
COLS_C = W_C
COLS_G = N_BRANCH * D_MODEL
P_IN = COLS_A + COLS_B + COLS_C + COLS_G
SPLITS = (W_A, 2 * W_A, 3 * W_A, 3 * W_A + W_B, COLS_A + COLS_B, COLS_A + COLS_B + COLS_C)

kernel_name = "hybrid_conv_pool_gated_block"


def rmsnorm(x, g):
    x32 = x.astype(jnp.float32)
    y = x32 * lax.rsqrt(jnp.mean(x32 * x32, axis=-1, keepdims=True) + EPS)
    return (y * g.astype(jnp.float32)).astype(x.dtype)


def layernorm(x, g, b):
    x32 = x.astype(jnp.float32)
    mu = jnp.mean(x32, axis=-1, keepdims=True)
    xc = x32 - mu
    var = jnp.mean(xc * xc, axis=-1, keepdims=True)
    y = xc * lax.rsqrt(var + EPS) * g.astype(jnp.float32) + b.astype(jnp.float32)
    return y.astype(x.dtype)


def causal_depthwise_conv(u, w):
    k, c = w.shape
    return lax.conv_general_dilated(
        u, w[:, None, :].astype(u.dtype), window_strides=(1,), padding=[(k - 1, 0)],
        dimension_numbers=("NWC", "WIO", "NWC"), feature_group_count=c)


def short_conv_mixer(b_gate, c_gate, xh, conv_w, w_out):
    z = causal_depthwise_conv(c_gate * xh, conv_w)
    return (b_gate * z) @ w_out


def conformer_conv_mixer(val, gate, conv_w, conv_b, ln_g, ln_b, w_out, b_out):
    u = val * jax.nn.sigmoid(gate)
    u = causal_depthwise_conv(u, conv_w) + conv_b
    u = jax.nn.silu(layernorm(u, ln_g, ln_b))
    return u @ w_out + b_out


def pool_mixer(u, w_pool, scale):
    seq = u.shape[1]
    u32 = u.astype(jnp.float32)
    cs = jnp.cumsum(u32, axis=1)
    t = jnp.arange(seq)
    parts = []
    for g, w in enumerate(POOL_WINDOWS):
        sl = slice(g * GC, (g + 1) * GC)
        c = cs[..., sl]
        prev = jnp.pad(c, ((0, 0), (w, 0), (0, 0)))[:, :seq]
        cnt = jnp.minimum(t + 1, w).astype(jnp.float32)[None, :, None]
        parts.append((c - prev) / cnt - u32[..., sl])
    p = jnp.stack(parts, axis=2).astype(u.dtype)
    y = jnp.einsum('bsgc,gcd->bsgd', p, w_pool)
    return y.reshape(u.shape[0], seq, W_C) * scale


def setup_inputs(seed: int = 0) -> dict:
    key = jax.random.key(seed)
    ks = jax.random.split(key, 20)
    L, D = DEPTH, D_MODEL
    f32 = jnp.float32

    def nrm(k, shape, fan_in):
        return jax.random.normal(k, shape, f32) * (fan_in ** -0.5)

    def gain(k, shape):
        return 1.0 + 0.02 * jax.random.normal(k, shape, f32)

    return {
        "x": jax.random.normal(ks[0], (BATCH, SEQ, D), f32),
        "g_mix": gain(ks[1], (L, D)),
        "w_in": nrm(ks[2], (L, D, P_IN), D),
        "b_in": 0.02 * jax.random.normal(ks[3], (L, P_IN), f32),
        "conv_a": nrm(ks[4], (L, K_A, W_A), K_A),
        "w_out_a": nrm(ks[5], (L, W_A, D), W_A),
        "conv_b": nrm(ks[6], (L, K_B, W_B), K_B),
        "conv_b_bias": 0.02 * jax.random.normal(ks[7], (L, W_B), f32),
        "ln_b_g": gain(ks[8], (L, W_B)),
        "ln_b_b": 0.02 * jax.random.normal(ks[9], (L, W_B), f32),
        "w_out_b": nrm(ks[10], (L, W_B, D), W_B),
        "b_out_b": 0.02 * jax.random.normal(ks[11], (L, D), f32),
        "w_pool": nrm(ks[12], (L, N_POOL_GROUPS, GC, GC), GC),
        "pool_scale": gain(ks[13], (L, W_C)),
        "w_o": nrm(ks[14], (L, D, D), D),
        "g_mlp": gain(ks[15], (L, D)),
        "w_mlp1": nrm(ks[16], (L, D, D_FF), D),
        "w_mlp2": nrm(ks[17], (L, D_FF, D), D_FF),
        "g_final": gain(ks[18], (D,)),
    }


def reference(x, g_mix, w_in, b_in, conv_a, w_out_a, conv_b, conv_b_bias, ln_b_g, ln_b_b,
              w_out_b, b_out_b, w_pool, pool_scale, w_o, g_mlp, w_mlp1, w_mlp2, g_final):
    bsz, seq, d = x.shape
    for l in range(DEPTH):
        h = rmsnorm(x, g_mix[l])
        proj = h @ w_in[l] + b_in[l]
        a_b, a_c, a_x, b_val, b_gate, c_in, gates = jnp.split(proj, SPLITS, axis=-1)
        y_a = short_conv_mixer(a_b, a_c, a_x, conv_a[l], w_out_a[l])
        y_b = conformer_conv_mixer(b_val, b_gate, conv_b[l], conv_b_bias[l], ln_b_g[l],
                                   ln_b_b[l], w_out_b[l], b_out_b[l])
        y_c = pool_mixer(c_in, w_pool[l], pool_scale[l])
        g = jax.nn.sigmoid(gates).reshape(bsz, seq, N_BRANCH, d)
        merged = g[:, :, 0] * y_a + g[:, :, 1] * y_b + g[:, :, 2] * y_c
        x = x + merged @ w_o[l]
        h = rmsnorm(x, g_mlp[l])
        x = x + jnp.square(jax.nn.relu(h @ w_mlp1[l])) @ w_mlp2[l]
    return rmsnorm(x, g_final)
```

```cpp
#include <hip/hip_runtime.h>
#include <hip/hip_cooperative_groups.h>
#include <cstdio>
#include <cstdint>
namespace cg = cooperative_groups;

#ifndef PH_MASK
#define PH_MASK 0xff
#endif
#ifndef MK_N_LAUNCHES
#define MK_N_LAUNCHES 1
#endif

#define LAS __attribute__((address_space(3)))
typedef unsigned short bf16_t;
typedef short bf16x8 __attribute__((ext_vector_type(8)));
typedef float f32x4 __attribute__((ext_vector_type(4)));
typedef float f32x2 __attribute__((ext_vector_type(2)));
typedef unsigned u32x4 __attribute__((ext_vector_type(4)));

constexpr int M = 16384, D = 1024, SEQ = 8192, PIN = 9216, FF = 4096, DEPTH = 2;
constexpr float EPS = 1e-6f;
constexpr int NPH = 7 * DEPTH + 1;

constexpr size_t MiB = 1u << 20;
constexpr size_t WS_WIN = 1 * MiB, WS_WA = 19 * MiB, WS_WB = 21 * MiB, WS_WP = 23 * MiB, WS_WO = 25 * MiB, WS_W1 = 27 * MiB, WS_W2 = 35 * MiB, WS_SSQ = 43 * MiB;
constexpr size_t WS_XB = 44 * MiB, WS_PA = 76 * MiB, WS_CA = 108 * MiB, WS_U = 140 * MiB, WS_CIN = 172 * MiB, WS_PB = 204 * MiB, WS_PC = 236 * MiB, WS_W2B = 268 * MiB, WS_END = 276 * MiB;
constexpr size_t WS_HID = WS_PA;
constexpr size_t WS_GQ0 = WS_CA, WS_GQ1 = WS_CA + 16 * MiB, WS_GQ2 = WS_U;
constexpr size_t WS_MRG = WS_CIN;
static_assert(WS_HID + (size_t)M * FF * 2 <= WS_PB && WS_GQ2 + (size_t)M * D <= WS_CIN && WS_MRG + (size_t)M * D * 2 <= WS_PB, "ws map");

constexpr int RING_BYTES = 131072, RS_BYTES = 16384, MISC_OFF = RING_BYTES + RS_BYTES, LDS_BYTES = MISC_OFF + 256;

#define OPAQUE(v) asm volatile("" : "+v"(v))
typedef __bf16 bf16x2_t __attribute__((ext_vector_type(2)));
__device__ __forceinline__ unsigned cvt_pk_bf16(float lo, float hi) { const f32x2 v = {lo, hi}; const bf16x2_t b = __builtin_convertvector(v, bf16x2_t); return __builtin_bit_cast(unsigned, b); }
__device__ __forceinline__ float bf_lo(unsigned w) { return __uint_as_float(w << 16); }
__device__ __forceinline__ float bf_hi(unsigned w) { return __uint_as_float(w & 0xffff0000u); }
__device__ __forceinline__ float sigm(float x) { return __builtin_amdgcn_rcpf(1.0f + __builtin_amdgcn_exp2f(-1.4426950408889634f * x)); }
__device__ __forceinline__ f32x4 sigm4(f32x4 v) { return (f32x4){sigm(v[0]), sigm(v[1]), sigm(v[2]), sigm(v[3])}; }
__device__ __forceinline__ u32x4 pack8(f32x4 a, f32x4 b) { u32x4 w; w.x = cvt_pk_bf16(a[0], a[1]); w.y = cvt_pk_bf16(a[2], a[3]); w.z = cvt_pk_bf16(b[0], b[1]); w.w = cvt_pk_bf16(b[2], b[3]); return w; }
__device__ __forceinline__ float row_rs(const float* ssq, int row) {
    const f32x4* p = (const f32x4*)(ssq + (size_t)row * 16); const f32x4 a = p[0], b = p[1], c = p[2], d = p[3];
    const float s = ((a[0] + a[1]) + (a[2] + a[3])) + ((b[0] + b[1]) + (b[2] + b[3])) + ((c[0] + c[1]) + (c[2] + c[3])) + ((d[0] + d[1]) + (d[2] + d[3]));
    return rsqrtf(s * (1.0f / D) + EPS);
}
__device__ __forceinline__ float shx(float v, int mask, int lane) { return __builtin_bit_cast(float, __builtin_amdgcn_ds_bpermute((lane ^ mask) << 2, __builtin_bit_cast(int, v))); }
__device__ __forceinline__ float wave_sum(float v, int lane) {
#pragma unroll
    for (int o = 1; o < 64; o <<= 1) v += shx(v, o, lane);
    return v;
}

namespace pg8 {
constexpr int BM = 256, BK = 64, HALF = 128, HTB = HALF * BK * 2, NXCD = 8, WGM = 8;
__host__ __device__ __forceinline__ int lds_byte(int r, int c) { const int st = (r >> 4) * 2 + (c >> 5), rr = r & 15, cc = c & 31, ob = rr * 64 + cc * 2; return st * 1024 + (ob ^ (((ob >> 9) & 1) << 5)); }
__host__ __device__ __forceinline__ void stage_rc(int b, int& R, int& C) { const int st = b / 1024, sb = b % 1024, swz = sb ^ (((sb >> 9) & 1) << 5); R = (st >> 1) * 16 + swz / 64; C = (st & 1) * 32 + (swz % 64) / 2; }
__host__ __device__ __forceinline__ int perm32(int rho) { const int n = rho >> 4, i = rho & 15; return 8 * (i >> 2) + 4 * n + (i & 3); }

struct Unit { int pm, pn, kind, nt, ord, n0, n1; const char* A; const char* B; const char* A1; const char* B1; const char* A2; const char* B2; };
struct Gemm { int lda, ldb; };

struct TileSched {
    int nM, nN, nwg, G, c;
    __device__ void init(int M_, int N_, int G_, int c_) { nM = M_ / BM; nN = N_ / BM; nwg = nM * nN; G = G_; c = c_; }
    __device__ bool tile(int i, int& pm, int& pn) const {
        const long L = (long)i * G + c; if (L >= nwg) return false;
        int wgid = (int)L; { const int q = nwg / NXCD, r = nwg % NXCD, xcd = wgid % NXCD, off = wgid / NXCD; wgid = (xcd < r ? xcd * (q + 1) : r * (q + 1) + (xcd - r) * q) + off; }
        const int nig = WGM * nN, gid = wgid / nig, fm = gid * WGM, gsz = (nM - fm) < WGM ? (nM - fm) : WGM;
        pm = fm + ((wgid % nig) % gsz); pn = (wgid % nig) / gsz; return true;
    }
};
struct SchedPlain {
    TileSched T; const char* A; const char* B; size_t atile, btile; int nt;
    __device__ bool next(int i, Unit& u) const { int pm, pn; if (!T.tile(i, pm, pn)) return false; u.pm = pm; u.pn = pn; u.kind = 0; u.nt = nt; u.ord = i; u.n0 = nt; u.n1 = nt; u.A = A + (size_t)pm * atile; u.B = B + (size_t)pn * btile; return true; }
};
struct SchedG2 {
    TileSched T; const char* ws;
    __device__ bool next(int i, Unit& u) const {
        const int ti = i >> 2, kind = i & 3; int pm, pn; if (!T.tile(ti, pm, pn)) return false;
        const size_t ar = (size_t)pm * (256 * 1024 * 2), br = (size_t)pn * (256 * 1024 * 2);
        u.pm = pm; u.pn = pn; u.kind = kind; u.ord = ti;
        if (kind < 3) { u.nt = 16; u.n0 = 16; u.n1 = 16; u.A = ws + WS_XB + ar; u.B = ws + WS_WIN + (size_t)6144 * 2048 + (size_t)kind * (1024 * 1024 * 2) + br; u.A1 = u.A; u.B1 = u.B; u.A2 = u.A; u.B2 = u.B; }
        else { u.nt = 36; u.n0 = 16; u.n1 = 32; u.A = ws + WS_PA + ar; u.B = ws + WS_WA + br; u.A1 = ws + WS_PB + ar; u.B1 = ws + WS_WB + br; u.A2 = ws + WS_PC + ar + (size_t)pn * 512; u.B2 = ws + WS_WP + br; }
        return true;
    }
};

template <class Epi, class Sched>
__device__ __forceinline__ void gemm_phase(LAS unsigned char* lds, const Gemm g, const Sched& S, const Epi& E) {
    int tid_ = threadIdx.x; OPAQUE(tid_);
    const int tid = tid_, wid = __builtin_amdgcn_readfirstlane(tid >> 6), lane = tid & 63, wr = wid >> 2, wc = wid & 3, fr = lane & 15, fq = lane >> 4;
    unsigned voffA[2], voffB[2];
#pragma unroll
    for (int i = 0; i < 2; ++i) { int R, C; stage_rc(tid * 16 + i * 8192, R, C); const int Rb = (R & ~31) + perm32(R & 31);
        voffA[i] = (unsigned)(R * g.lda + C) * 2u; voffB[i] = (unsigned)(Rb * g.ldb + C) * 2u; }
    const size_t kstep = (size_t)(BK * 2);
    const size_t hstepA = (size_t)HALF * g.lda * 2, hstepB = (size_t)HALF * g.ldb * 2;
    const unsigned ldsw = (unsigned)wid * 1024u;
    const int aoff = lds_byte(wr * 64 + fr, fq * 8), boff = lds_byte(wc * 32 + fr, fq * 8);
#define PG8_SA(b, h) (((b) * 2 + (h)) * HTB)
#define PG8_SB(b, h) ((4 + (b) * 2 + (h)) * HTB)
#define PG8_STAGE(bufoff, gbase, voff) do { _Pragma("unroll") for (int _i = 0; _i < 2; ++_i) \
        __builtin_amdgcn_global_load_lds((const unsigned*)((const char*)(gbase) + (voff)[_i]), (LAS unsigned*)(lds + (bufoff) + ldsw + _i * 8192), 16, 0, 0); } while (0)
#define PG8_LDA(dst, b, h) do { _Pragma("unroll") for (int m = 0; m < 4; ++m) _Pragma("unroll") for (int k = 0; k < 2; ++k) dst[m][k] = *(const LAS bf16x8*)(lds + PG8_SA(b, h) + aoff + m * 2048 + k * 1024); } while (0)
#define PG8_LDB(dst, b, h) do { _Pragma("unroll") for (int n = 0; n < 2; ++n) _Pragma("unroll") for (int k = 0; k < 2; ++k) dst[n][k] = *(const LAS bf16x8*)(lds + PG8_SB(b, h) + boff + n * 2048 + k * 1024); } while (0)
#define PG8_MMA(ai, bj, At, Bt) do { __builtin_amdgcn_s_setprio(1); _Pragma("unroll") for (int m = 0; m < 4; ++m) _Pragma("unroll") for (int n = 0; n < 2; ++n) _Pragma("unroll") for (int k = 0; k < 2; ++k) \
        acc[ai][bj][m][n] = __builtin_amdgcn_mfma_f32_16x16x32_bf16(Bt[n][k], At[m][k], acc[ai][bj][m][n], 0, 0, 0); __builtin_amdgcn_s_setprio(0); } while (0)
#define PG8_WAIT_V(n) asm volatile("s_waitcnt vmcnt(" #n ")" ::: "memory")
#define PG8_WAIT_L(n) asm volatile("s_waitcnt lgkmcnt(" #n ")" ::: "memory")
#define PG8_BAR __builtin_amdgcn_s_barrier()
#define PG8_SCHED __builtin_amdgcn_sched_barrier(0)
    Unit cur, nxt; int ui = 0;
    if (!S.next(0, cur)) return;
    f32x4 acc[2][2][4][2];
#pragma unroll
    for (int a = 0; a < 2; ++a)
#pragma unroll
        for (int b = 0; b < 2; ++b)
#pragma unroll
            for (int m = 0; m < 4; ++m)
#pragma unroll
                for (int n = 0; n < 2; ++n) acc[a][b][m][n] = (f32x4){0.f, 0.f, 0.f, 0.f};
    bf16x8 At[4][2], B0[2][2], B1[2][2];
    const char* cA = cur.A; const char* cB = cur.B;
    PG8_STAGE(PG8_SB(0, 0), cB, voffB); PG8_STAGE(PG8_SB(0, 1), cB + hstepB, voffB); PG8_STAGE(PG8_SA(0, 0), cA, voffA); PG8_STAGE(PG8_SA(0, 1), cA + hstepA, voffA);
    if (wr == 1) PG8_BAR;
    PG8_WAIT_V(2); PG8_BAR;
    PG8_STAGE(PG8_SB(1, 0), cB + kstep, voffB); PG8_STAGE(PG8_SA(1, 0), cA + kstep, voffA); PG8_STAGE(PG8_SB(1, 1), cB + hstepB + kstep, voffB);
    PG8_WAIT_V(6); PG8_BAR;
    for (;;) {
        const bool has_next = S.next(ui + 1, nxt);
        const char* nA = has_next ? nxt.A : cA; const char* nB = has_next ? nxt.B : cB;
        const int nt = cur.nt;
        for (int t = 0; t < nt; t += 2) {
            const bool last = (t == nt - 2);
            const char *a1, *a2, *b2;
            if constexpr (Epi::HAS_MID) {
                const int t2 = t + 2;
                a1 = (t < cur.n0 ? cur.A + (size_t)t * kstep : (t < cur.n1 ? cur.A1 + (size_t)(t - cur.n0) * kstep : cur.A2 + (size_t)(t - cur.n1) * kstep)) + kstep;
                a2 = last ? nA : (t2 < cur.n0 ? cur.A + (size_t)t2 * kstep : (t2 < cur.n1 ? cur.A1 + (size_t)(t2 - cur.n0) * kstep : cur.A2 + (size_t)(t2 - cur.n1) * kstep));
                b2 = last ? nB : (t2 < cur.n0 ? cur.B + (size_t)t2 * kstep : (t2 < cur.n1 ? cur.B1 + (size_t)(t2 - cur.n0) * kstep : cur.B2 + (size_t)(t2 - cur.n1) * kstep));
            } else {
                a1 = cA + (size_t)(t + 1) * kstep;
                a2 = last ? nA : cA + (size_t)(t + 2) * kstep; b2 = last ? nB : cB + (size_t)(t + 2) * kstep;
            }
            const char* a3 = a2 + kstep; const char* b3 = b2 + kstep;
            PG8_LDB(B0, 0, 0); PG8_LDB(B1, 0, 1); PG8_SCHED; PG8_LDA(At, 0, 0); PG8_STAGE(PG8_SA(1, 1), a1 + hstepA, voffA);
            PG8_WAIT_V(8); PG8_WAIT_L(0); PG8_BAR; PG8_MMA(0, 0, At, B0); PG8_MMA(0, 1, At, B1); PG8_BAR; PG8_SCHED;
            PG8_LDA(At, 0, 1); PG8_STAGE(PG8_SB(0, 0), b2, voffB); PG8_STAGE(PG8_SB(0, 1), b2 + hstepB, voffB); PG8_STAGE(PG8_SA(0, 0), a2, voffA);
            PG8_WAIT_V(8); PG8_WAIT_L(0); PG8_BAR; PG8_MMA(1, 0, At, B0); PG8_MMA(1, 1, At, B1); PG8_BAR; PG8_SCHED;
            PG8_LDB(B0, 1, 0); PG8_LDB(B1, 1, 1); PG8_SCHED; PG8_LDA(At, 1, 0); PG8_STAGE(PG8_SA(0, 1), a2 + hstepA, voffA);
            PG8_WAIT_V(8); PG8_WAIT_L(0); PG8_BAR; PG8_MMA(0, 0, At, B0); PG8_MMA(0, 1, At, B1); PG8_BAR; PG8_SCHED;
            PG8_LDA(At, 1, 1); PG8_STAGE(PG8_SB(1, 0), b3, voffB); PG8_STAGE(PG8_SB(1, 1), b3 + hstepB, voffB); PG8_STAGE(PG8_SA(1, 0), a3, voffA);
            PG8_WAIT_V(8); PG8_WAIT_L(0); PG8_BAR; PG8_MMA(1, 0, At, B0); PG8_MMA(1, 1, At, B1); PG8_BAR; PG8_SCHED;
            if constexpr (Epi::HAS_MID) {
                if (t + 2 < nt && (t + 2 == cur.n0 || t + 2 == cur.n1)) {
                    if (wr == 0) PG8_BAR;
                    E.mid(acc, cur, t + 2 == cur.n0 ? 0 : 1, wr, wc, fr, fq); PG8_SCHED;
                    if (wr == 1) PG8_BAR;
                }
            }
        }
        if (wr == 0) PG8_BAR;
        E(acc, cur, wr, wc, fr, fq);
        if (!has_next) break;
#pragma unroll
        for (int a = 0; a < 2; ++a)
#pragma unroll
            for (int b = 0; b < 2; ++b)
#pragma unroll
                for (int m = 0; m < 4; ++m)
#pragma unroll
                    for (int n = 0; n < 2; ++n) acc[a][b][m][n] = (f32x4){0.f, 0.f, 0.f, 0.f};
        cur = nxt; cA = nA; cB = nB; ++ui;
        if (wr == 1) PG8_BAR;
    }
    PG8_WAIT_V(0);
    PG8_BAR;
#undef PG8_SA
#undef PG8_SB
#undef PG8_STAGE
#undef PG8_LDA
#undef PG8_LDB
#undef PG8_MMA
#undef PG8_WAIT_V
#undef PG8_WAIT_L
#undef PG8_BAR
#undef PG8_SCHED
}

typedef f32x4 Acc[2][2][4][2];
#define GAS __attribute__((address_space(1)))
__device__ __forceinline__ f32x4 ldg4f(const float* p) { return *(const GAS f32x4*)p; }
__device__ __forceinline__ u32x4 ldg4u(const void* p) { return *(const GAS u32x4*)p; }
__device__ __forceinline__ void stg4f(float* p, f32x4 v) { *(GAS f32x4*)p = v; }
__device__ __forceinline__ void stg4u(void* p, u32x4 v) { *(GAS u32x4*)p = v; }
__device__ __forceinline__ f32x4 bfx4_lo(u32x4 w) { return (f32x4){bf_lo(w.x), bf_hi(w.x), bf_lo(w.y), bf_hi(w.y)}; }
__device__ __forceinline__ f32x4 bfx4_hi(u32x4 w) { return (f32x4){bf_lo(w.z), bf_hi(w.z), bf_lo(w.w), bf_hi(w.w)}; }

constexpr int RS_MAX_ORD = 16;
__device__ __forceinline__ void rs_table_fill(LAS float* rsl, int ord, int pm, const float* ssq) {
    int t_ = threadIdx.x; OPAQUE(t_); const int t = t_, r = t >> 1, h = t & 1;
    const float* p = ssq + (size_t)(pm * BM + r) * 16 + h * 8; const f32x4 a = ldg4f(p), b = ldg4f(p + 4);
    float s = ((a[0] + a[1]) + (a[2] + a[3])) + ((b[0] + b[1]) + (b[2] + b[3]));
    s += shx(s, 1, t & 63);
    if (h == 0) rsl[ord * BM + r] = rsqrtf(s * (1.0f / D) + EPS);
}
__device__ __forceinline__ float rs_get(const LAS float* rsl, const float* ssq, int ord, int lrow, int row) { return ord < RS_MAX_ORD ? rsl[ord * BM + lrow] : row_rs(ssq, row); }

struct EpiG1 {
    static constexpr bool HAS_MID = false;
    unsigned char* ws; const float* b_in; const float* ssq; const LAS float* rsl;
    __device__ __forceinline__ void operator()(const Acc& acc, const Unit& u, int wr, int wc, int fr, int fq) const {
        const int lrow0 = wr * 64 + fr, row0 = u.pm * BM + lrow0, cc = wc * 32 + 8 * fq, pn = u.pn;
        float rs[2][4];
#pragma unroll
        for (int ai = 0; ai < 2; ++ai)
#pragma unroll
            for (int m = 0; m < 4; ++m) rs[ai][m] = rs_get(rsl, ssq, u.ord, lrow0 + ai * HALF + m * 16, row0 + ai * HALF + m * 16);
        if (pn < 4 || pn >= 20) {
            bf16_t* dst = (bf16_t*)(ws + (pn < 4 ? WS_PA : WS_CIN)); const int cb = (pn < 4 ? pn : pn - 20) * 256; const float* bs = b_in + (pn < 4 ? 0 : 5120) + cb + cc;
            f32x4 bv[2][2];
#pragma unroll
            for (int bj = 0; bj < 2; ++bj)
#pragma unroll
                for (int n = 0; n < 2; ++n) bv[bj][n] = ldg4f(bs + bj * HALF + 4 * n);
#pragma unroll
            for (int ai = 0; ai < 2; ++ai)
#pragma unroll
                for (int m = 0; m < 4; ++m) { const int row = row0 + ai * HALF + m * 16; const float r = rs[ai][m]; bf16_t* rowp = dst + (size_t)row * D + cb + cc;
#pragma unroll
                    for (int bj = 0; bj < 2; ++bj) stg4u(rowp + bj * HALF, pack8(acc[ai][bj][m][0] * r + bv[bj][0], acc[ai][bj][m][1] * r + bv[bj][1])); }
        } else {
            const bool glu = pn >= 12; const int q = glu ? pn - 12 : pn - 4; const int col = q * 128 + cc;
            bf16_t* dst = (bf16_t*)(ws + (glu ? WS_U : WS_CA)); const float* b0 = b_in + (glu ? 3072 : 1024) + col; const float* b1 = b0 + 1024;
            f32x4 bv[2][2];
#pragma unroll
            for (int n = 0; n < 2; ++n) { bv[0][n] = ldg4f(b0 + 4 * n); bv[1][n] = ldg4f(b1 + 4 * n); }
#pragma unroll
            for (int ai = 0; ai < 2; ++ai)
#pragma unroll
                for (int m = 0; m < 4; ++m) { const int row = row0 + ai * HALF + m * 16; const float r = rs[ai][m];
                    f32x4 p0 = acc[ai][0][m][0] * r + bv[0][0], p1 = acc[ai][0][m][1] * r + bv[0][1], q0 = acc[ai][1][m][0] * r + bv[1][0], q1 = acc[ai][1][m][1] * r + bv[1][1];
                    if (glu) { q0 = sigm4(q0); q1 = sigm4(q1); }
                    stg4u(dst + (size_t)row * D + col, pack8(p0 * q0, p1 * q1)); }
        }
    }
};

typedef unsigned u32x2 __attribute__((ext_vector_type(2)));
__device__ __forceinline__ unsigned pack_q4(f32x4 g) {
    const f32x4 t = g * 255.0f + 0.5f; unsigned w = 0u;
    w = __builtin_amdgcn_cvt_pk_u8_f32(t[0], 0, w); w = __builtin_amdgcn_cvt_pk_u8_f32(t[1], 1, w); w = __builtin_amdgcn_cvt_pk_u8_f32(t[2], 2, w); w = __builtin_amdgcn_cvt_pk_u8_f32(t[3], 3, w); return w;
}
__device__ __forceinline__ f32x4 dec_q4(unsigned w) {
    const f32x4 q = (f32x4){(float)(w & 0xffu), (float)((w >> 8) & 0xffu), (float)((w >> 16) & 0xffu), (float)(w >> 24)};
    return __builtin_elementwise_max(q, (f32x4){0.5f, 0.5f, 0.5f, 0.5f}) * (1.0f / 255.0f);
}
__device__ __forceinline__ f32x4 rcp4(f32x4 v) { return (f32x4){__builtin_amdgcn_rcpf(v[0]), __builtin_amdgcn_rcpf(v[1]), __builtin_amdgcn_rcpf(v[2]), __builtin_amdgcn_rcpf(v[3])}; }
struct EpiG2 {
    static constexpr bool HAS_MID = true;
    unsigned char* ws; const float* bg; const float* bb; const float* scale; const float* ssq; const LAS float* rsl;
    __device__ __forceinline__ void mid(Acc& acc, const Unit& u, int which, int wr, int wc, int fr, int fq) const {
        const int row0 = u.pm * BM + wr * 64 + fr, cc = u.pn * BM + wc * 32 + 8 * fq;
        const size_t base = (size_t)row0 * D + cc;
        const unsigned char* GN = ws + (which == 0 ? WS_GQ0 : WS_GQ1); const unsigned char* GD = ws + (which == 0 ? WS_GQ1 : WS_GQ2);
        f32x4 bv[2][2];
#pragma unroll
        for (int bj = 0; bj < 2; ++bj)
#pragma unroll
            for (int n = 0; n < 2; ++n) bv[bj][n] = which ? ldg4f(bb + cc + bj * HALF + 4 * n) : (f32x4){0.f, 0.f, 0.f, 0.f};
#pragma unroll
        for (int ai = 0; ai < 2; ++ai) {
            u32x2 qn[4][2], qd[4][2];
#pragma unroll
            for (int m = 0; m < 4; ++m)
#pragma unroll
                for (int bj = 0; bj < 2; ++bj) { const size_t off = base + (size_t)(ai * HALF + m * 16) * D + bj * HALF; qn[m][bj] = *(const GAS u32x2*)(GN + off); qd[m][bj] = *(const GAS u32x2*)(GD + off); }
#pragma unroll
            for (int m = 0; m < 4; ++m)
#pragma unroll
                for (int bj = 0; bj < 2; ++bj) {
                    acc[ai][bj][m][0] = (acc[ai][bj][m][0] + bv[bj][0]) * dec_q4(qn[m][bj].x) * rcp4(dec_q4(qd[m][bj].x));
                    acc[ai][bj][m][1] = (acc[ai][bj][m][1] + bv[bj][1]) * dec_q4(qn[m][bj].y) * rcp4(dec_q4(qd[m][bj].y)); }
        }
    }
    __device__ __forceinline__ void operator()(const Acc& acc, const Unit& u, int wr, int wc, int fr, int fq) const {
        const int lrow0 = wr * 64 + fr, row0 = u.pm * BM + lrow0, cc = u.pn * BM + wc * 32 + 8 * fq, kind = u.kind;
        const size_t base = (size_t)row0 * D + cc;
        if (kind < 3) {
            unsigned char* GQ = ws + (kind == 0 ? WS_GQ0 : (kind == 1 ? WS_GQ1 : WS_GQ2));
            const float* b = bg + kind * 1024 + cc;
            f32x4 bv[2][2];
#pragma unroll
            for (int bj = 0; bj < 2; ++bj)
#pragma unroll
                for (int n = 0; n < 2; ++n) bv[bj][n] = ldg4f(b + bj * HALF + 4 * n);
#pragma unroll
            for (int ai = 0; ai < 2; ++ai)
#pragma unroll
                for (int m = 0; m < 4; ++m) { const float r = rs_get(rsl, ssq, u.ord, lrow0 + ai * HALF + m * 16, row0 + ai * HALF + m * 16);
#pragma unroll
                    for (int bj = 0; bj < 2; ++bj) { u32x2 q; q.x = pack_q4(sigm4(acc[ai][bj][m][0] * r + bv[bj][0])); q.y = pack_q4(sigm4(acc[ai][bj][m][1] * r + bv[bj][1]));
                        *(GAS u32x2*)(GQ + base + (size_t)(ai * HALF + m * 16) * D + bj * HALF) = q; } }
        } else {
            const unsigned char* GN = ws + WS_GQ2;
            u32x2 qn[2][4][2];
#pragma unroll
            for (int ai = 0; ai < 2; ++ai)
#pragma unroll
                for (int m = 0; m < 4; ++m)
#pragma unroll
                    for (int bj = 0; bj < 2; ++bj) qn[ai][m][bj] = *(const GAS u32x2*)(GN + base + (size_t)(ai * HALF + m * 16) * D + bj * HALF);
#pragma unroll
            for (int ai = 0; ai < 2; ++ai)
#pragma unroll
                for (int m = 0; m < 4; ++m)
#pragma unroll
                    for (int bj = 0; bj < 2; ++bj) stg4u((bf16_t*)(ws + WS_MRG) + base + (size_t)(ai * HALF + m * 16) * D + bj * HALF,
                        pack8(acc[ai][bj][m][0] * dec_q4(qn[ai][m][bj].x), acc[ai][bj][m][1] * dec_q4(qn[ai][m][bj].y)));
        }
    }
};

struct EpiX {
    static constexpr bool HAS_MID = false;
    bf16_t* XB; float* ssq;
    __device__ __forceinline__ void operator()(const Acc& acc, const Unit& u, int wr, int wc, int fr, int fq) const {
        const int row0 = u.pm * BM + wr * 64 + fr, cc = u.pn * BM + wc * 32 + 8 * fq;
        u32x4 bs[2][4][2];
#pragma unroll
        for (int ai = 0; ai < 2; ++ai)
#pragma unroll
            for (int m = 0; m < 4; ++m)
#pragma unroll
                for (int bj = 0; bj < 2; ++bj) bs[ai][m][bj] = ldg4u(XB + (size_t)(row0 + ai * HALF + m * 16) * D + cc + bj * HALF);
#pragma unroll
        for (int ai = 0; ai < 2; ++ai)
#pragma unroll
            for (int m = 0; m < 4; ++m) { const int row = row0 + ai * HALF + m * 16; float ss = 0.f;
#pragma unroll
                for (int bj = 0; bj < 2; ++bj) { const size_t off = (size_t)row * D + cc + bj * HALF;
                    const f32x4 v0 = bfx4_lo(bs[ai][m][bj]) + acc[ai][bj][m][0], v1 = bfx4_hi(bs[ai][m][bj]) + acc[ai][bj][m][1];
                    stg4u(XB + off, pack8(v0, v1));
                    ss += ((v0[0] * v0[0] + v0[1] * v0[1]) + (v0[2] * v0[2] + v0[3] * v0[3])) + ((v1[0] * v1[0] + v1[1] * v1[1]) + (v1[2] * v1[2] + v1[3] * v1[3])); }
                ss += shx(ss, 16, fq * 16 + (row0 & 15)); ss += shx(ss, 32, fq * 16 + (row0 & 15));
                if (fq == 0) *(GAS float*)(ssq + (size_t)row * 16 + u.pn * 4 + wc) = ss; }
    }
};

struct EpiG4 {
    static constexpr bool HAS_MID = false;
    bf16_t* HID; const float* ssq; const LAS float* rsl;
    __device__ __forceinline__ void operator()(const Acc& acc, const Unit& u, int wr, int wc, int fr, int fq) const {
        const int lrow0 = wr * 64 + fr, row0 = u.pm * BM + lrow0, cc = u.pn * BM + wc * 32 + 8 * fq;
#pragma unroll
        for (int ai = 0; ai < 2; ++ai)
#pragma unroll
            for (int m = 0; m < 4; ++m) { const int row = row0 + ai * HALF + m * 16; const float rs = rs_get(rsl, ssq, u.ord, lrow0 + ai * HALF + m * 16, row);
#pragma unroll
                for (int bj = 0; bj < 2; ++bj) { f32x4 v0 = acc[ai][bj][m][0] * rs, v1 = acc[ai][bj][m][1] * rs;
                    v0 = __builtin_elementwise_max(v0, (f32x4){0.f, 0.f, 0.f, 0.f}); v1 = __builtin_elementwise_max(v1, (f32x4){0.f, 0.f, 0.f, 0.f});
                    stg4u(HID + (size_t)row * FF + cc + bj * HALF, pack8(v0 * v0, v1 * v1)); } }
    }
};
}

__device__ __forceinline__ void tr_item(const float* W, int ldw, const float* gain, bf16_t* WT, int ldd, int k0, int n0, int drow0, LAS float* scr, int lane, const float* ngain = nullptr) {
    float wv[32];
    const float* wp = W + (size_t)(k0 + (lane >> 5)) * ldw + n0 + (lane & 31);
#pragma unroll
    for (int i = 0; i < 32; ++i) wv[i] = *(const GAS float*)(wp + (size_t)(2 * i) * ldw);
    float gv0 = 1.0f;
    if (gain) gv0 = gain[k0 + lane];
#pragma unroll
    for (int i = 0; i < 32; ++i) { const int kk = 2 * i + (lane >> 5); const float gv = gain ? __builtin_bit_cast(float, __builtin_amdgcn_ds_bpermute(kk << 2, __builtin_bit_cast(int, gv0))) : 1.0f; scr[kk * 33 + (lane & 31)] = wv[i] * gv; }
    asm volatile("s_waitcnt lgkmcnt(0)" ::: "memory");
    const int c = lane & 7;
#pragma unroll
    for (int j = 0; j < 4; ++j) { const int n = (lane >> 3) + 8 * j; const LAS float* s = scr + (8 * c) * 33 + n; const float ng = ngain ? ngain[n] : 1.0f;
        u32x4 o; o.x = cvt_pk_bf16(s[0 * 33] * ng, s[1 * 33] * ng); o.y = cvt_pk_bf16(s[2 * 33] * ng, s[3 * 33] * ng); o.z = cvt_pk_bf16(s[4 * 33] * ng, s[5 * 33] * ng); o.w = cvt_pk_bf16(s[6 * 33] * ng, s[7 * 33] * ng);
        *(u32x4*)(WT + (size_t)(drow0 + n) * ldd + k0 + 8 * c) = o; }
    asm volatile("s_waitcnt lgkmcnt(0)" ::: "memory");
}
__device__ __forceinline__ int win_row(int n) {
    if (n < 1024 || n >= 5120) return n;
    const int base = n < 3072 ? 1024 : 3072, j = n - base, which = j >> 10, jj = j & 1023;
    return base + (jj >> 7) * 256 + which * 128 + (jj & 127);
}

struct Args { const float* in[19]; float* out; unsigned char* ws; int ph_lo, ph_hi; };

__device__ __forceinline__ f32x2 unpk(unsigned w) { return (f32x2){bf_lo(w), bf_hi(w)}; }
template <int W>
__device__ __forceinline__ void pool_compute(const unsigned (&raw)[47], GAS char* PCg, unsigned ooff, int t0) {
    constexpr int H = W - 1, B0 = 15 - H;
    f32x2 S = (f32x2){0.f, 0.f};
#pragma unroll
    for (int j = 0; j < H; ++j) S += unpk(raw[B0 + j]);
#pragma unroll
    for (int i = 0; i < 32; ++i) {
        const f32x2 v = unpk(raw[15 + i]);
        S += v;
        const float inv = (t0 > 0 || i + 1 >= W) ? (1.0f / W) : (1.0f / (float)(i + 1));
        const f32x2 o = S * inv - v;
        *(GAS unsigned*)(PCg + ooff) = cvt_pk_bf16(o.x, o.y); ooff += D * 2; OPAQUE(ooff);
        S -= unpk(raw[B0 + i]);
    }
}
__device__ __forceinline__ void e_branch_a(GAS char* PAg, const GAS char* CAg, const float* conv_a, unsigned off0, int t0, int c0) {
    {
        unsigned craw[34], braw[32];
        { unsigned off = off0;
#pragma unroll
          for (int j = 0; j < 34; ++j) { craw[j] = *(const GAS unsigned*)(CAg + off); off += D * 2; OPAQUE(off); } }
        { unsigned off = off0;
#pragma unroll
          for (int i = 0; i < 32; ++i) { braw[i] = *(const GAS unsigned*)(PAg + off); off += D * 2; OPAQUE(off); } }
        const f32x2 w0 = *(const GAS f32x2*)(conv_a + c0), w1 = *(const GAS f32x2*)(conv_a + D + c0), w2 = *(const GAS f32x2*)(conv_a + 2 * D + c0);
        if (t0 == 0) { craw[0] = 0u; craw[1] = 0u; }
        unsigned off = off0;
#pragma unroll
        for (int i = 0; i < 32; ++i) {
            const f32x2 z = w0 * unpk(craw[i]) + w1 * unpk(craw[i + 1]) + w2 * unpk(craw[i + 2]);
            const f32x2 o = z * unpk(braw[i]);
            *(GAS unsigned*)(PAg + off) = cvt_pk_bf16(o.x, o.y); off += D * 2; OPAQUE(off);
        }
    }
}
__device__ __forceinline__ void e_branch_c(const GAS char* CINg, GAS char* PCg, unsigned off0, int t0, int wave) {
    {
        unsigned praw[47];
        { unsigned off = off0;
#pragma unroll
          for (int j = 0; j < 47; ++j) { praw[j] = *(const GAS unsigned*)(CINg + off); off += D * 2; OPAQUE(off); } }
        if (t0 == 0) {
#pragma unroll
            for (int j = 0; j < 15; ++j) praw[j] = 0u;
        }
        if (wave < 2) pool_compute<2>(praw, PCg, off0, t0);
        else if (wave < 4) pool_compute<4>(praw, PCg, off0, t0);
        else if (wave < 6) pool_compute<8>(praw, PCg, off0, t0);
        else pool_compute<16>(praw, PCg, off0, t0);
    }
}
__device__ __forceinline__ void e_branch_b_conv(const GAS char* Ug, const f32x2 (&wk)[31], f32x2 cb, LAS f32x2* conv, unsigned off0, int t0, int tid, int ch_lo, int ch_hi) {
#pragma unroll 1
    for (int ch = ch_lo; ch < ch_hi; ++ch) {
        unsigned uraw[38];
        unsigned off = off0 + (unsigned)(ch * 8 * D * 2);
#pragma unroll
        for (int j = 0; j < 38; ++j) { uraw[j] = *(const GAS unsigned*)(Ug + off); off += D * 2; OPAQUE(off); }
        f32x2 uf[38];
#pragma unroll
        for (int j = 0; j < 38; ++j) uf[j] = ((t0 > 0) || (ch * 8 + j - 30 >= 0)) ? unpk(uraw[j]) : (f32x2){0.f, 0.f};
#pragma unroll
        for (int i = 0; i < 8; ++i) { f32x2 acc = cb;
#pragma unroll
            for (int k = 0; k < 31; ++k) acc += wk[k] * uf[i + k];
            conv[(ch * 8 + i) * 512 + tid] = acc; }
    }
}
__device__ __forceinline__ int opaque_idx_e(int k) { asm volatile("" : "+s"(k)); return k; }
__device__ __forceinline__ void e_phase(LAS unsigned char* lds, const Args& a, unsigned char* ws, int l, int G) {
    GAS char* PAg = (GAS char*)(ws + WS_PA); const GAS char* CAg = (const GAS char*)(ws + WS_CA) - 2 * D * 2; const GAS char* Ug = (const GAS char*)(ws + WS_U) - 30 * D * 2;
    const GAS char* CINg = (const GAS char*)(ws + WS_CIN) - 15 * D * 2; GAS char* PCg = (GAS char*)(ws + WS_PC); bf16_t* PB = (bf16_t*)(ws + WS_PB);
    const float* conv_a = a.in[opaque_idx_e(4)] + (size_t)l * 3 * D; const float* conv_b = a.in[opaque_idx_e(6)] + (size_t)l * 31 * D; const float* cbias = a.in[opaque_idx_e(7)] + (size_t)l * D;
    const float* ln_g = a.in[opaque_idx_e(8)] + (size_t)l * D; const float* ln_b = a.in[opaque_idx_e(9)] + (size_t)l * D;
    int tid_ = threadIdx.x; OPAQUE(tid_);
    const int tid = tid_, lane = tid & 63, wave = __builtin_amdgcn_readfirstlane(tid >> 6), c0 = 2 * tid;
    LAS f32x2* conv = (LAS f32x2*)lds;
    f32x2 wk[31];
#pragma unroll
    for (int k = 0; k < 31; ++k) wk[k] = *(const GAS f32x2*)(conv_b + (size_t)k * D + c0);
    const f32x2 cb = *(const GAS f32x2*)(cbias + c0);
    for (int it = blockIdx.x; it < M / 32; it += G) {
        const int m0 = it * 32, t0 = m0 & (SEQ - 1);
        const unsigned off0 = (unsigned)(m0 * D + c0) * 2u;
        if (wave < 4) { e_branch_a(PAg, CAg, conv_a, off0, t0, c0); e_branch_b_conv(Ug, wk, cb, conv, off0, t0, tid, 0, 2); e_branch_c(CINg, PCg, off0, t0, wave); e_branch_b_conv(Ug, wk, cb, conv, off0, t0, tid, 2, 4); }
        else          { e_branch_b_conv(Ug, wk, cb, conv, off0, t0, tid, 0, 2); e_branch_a(PAg, CAg, conv_a, off0, t0, c0); e_branch_b_conv(Ug, wk, cb, conv, off0, t0, tid, 2, 4); e_branch_c(CINg, PCg, off0, t0, wave); }
        __syncthreads();
        {
            f32x4 lg[4], lb[4];
#pragma unroll
            for (int j = 0; j < 4; ++j) { lg[j] = *(const GAS f32x4*)(ln_g + 4 * lane + 256 * j); lb[j] = *(const GAS f32x4*)(ln_b + 4 * lane + 256 * j); }
#pragma unroll 1
            for (int r = 0; r < 4; ++r) { const int row = wave * 4 + r;
                f32x4 v[4]; float s1 = 0.f, s2 = 0.f;
#pragma unroll
                for (int j = 0; j < 4; ++j) { v[j] = *(const LAS f32x4*)((const LAS float*)conv + row * 1024 + 4 * lane + 256 * j);
                    s1 += (v[j][0] + v[j][1]) + (v[j][2] + v[j][3]); s2 += (v[j][0] * v[j][0] + v[j][1] * v[j][1]) + (v[j][2] * v[j][2] + v[j][3] * v[j][3]); }
                s1 = wave_sum(s1, lane); s2 = wave_sum(s2, lane);
                const float mean = s1 * (1.0f / D); float var = s2 * (1.0f / D) - mean * mean; var = var > 0.f ? var : 0.f;
                const float rstd = rsqrtf(var + EPS);
                GAS unsigned long long* o8 = (GAS unsigned long long*)(PB + (size_t)(m0 + row) * D) + lane;
#pragma unroll
                for (int j = 0; j < 4; ++j) { const f32x4 y = (v[j] - mean) * rstd * lg[j] + lb[j];
                    o8[64 * j] = (unsigned long long)cvt_pk_bf16(y[0] * sigm(y[0]), y[1] * sigm(y[1])) | ((unsigned long long)cvt_pk_bf16(y[2] * sigm(y[2]), y[3] * sigm(y[3])) << 32); }
            }
        }
        __syncthreads();
    }
}

#define XB_TMO      128
#define XB_XCNT(j)  (256  + 64 * (j))
#define XB_XSUB(j)  (1280 + 64 * (j))
#define XB_XGEN(j)  (2304 + 64 * (j))
#define XB_TOP      3328
#define XB_TOPGEN   3392
#define XCD_BAR_WORDS 3456
#define XB_SPIN_CAP (1u << 18)
__device__ __forceinline__ unsigned xb_ld(unsigned* p)              { return __hip_atomic_load(p, __ATOMIC_RELAXED, __HIP_MEMORY_SCOPE_AGENT); }
__device__ __forceinline__ unsigned xb_add(unsigned* p, unsigned v) { return __hip_atomic_fetch_add(p, v, __ATOMIC_RELAXED, __HIP_MEMORY_SCOPE_AGENT); }
__device__ __forceinline__ unsigned xb_xcc_id() { return (unsigned)__builtin_amdgcn_s_getreg((3 << 11) | 20) & 0xFu; }
#define XB_SPIN(cond, bar) do { unsigned _sp = 0; while (cond) { __builtin_amdgcn_s_sleep(1); \
    if ((++_sp & 255u) == 0u) { if (xb_ld(&(bar)[XB_TMO])) break; if (_sp > XB_SPIN_CAP) { atomicAdd(&(bar)[XB_TMO], 1u); break; } } } } while (0)
__device__ __forceinline__ void xcd_barrier_complete(unsigned* bar, unsigned x, unsigned& nloc, unsigned& nx) {
    const unsigned G = gridDim.x * gridDim.y * gridDim.z;
    unsigned sum, cnt, mine, sp = 0u;
    for (;;) {
        sum = 0u; cnt = 0u; mine = 0u;
#pragma unroll
        for (unsigned j = 0; j < 16; ++j) { const unsigned c = xb_ld(&bar[XB_XCNT(j)]); sum += c; cnt += (c > 0u) ? 1u : 0u; mine = (j == x) ? c : mine; }
        if (sum == G) break;
        __builtin_amdgcn_s_sleep(1);
        if ((++sp & 255u) == 0u) { if (xb_ld(&bar[XB_TMO])) break; if (sp > XB_SPIN_CAP) { atomicAdd(&bar[XB_TMO], 1u); break; } }
    }
    nloc = mine > 0u ? mine : 1u; nx = cnt > 0u ? cnt : 1u;
}
__device__ __forceinline__ void xcd_barrier(unsigned* bar, volatile LAS unsigned* st) {
    asm volatile("s_waitcnt vmcnt(0)" ::: "memory");
    __syncthreads();
    if (threadIdx.x == 0) {
        __builtin_amdgcn_s_waitcnt(0);
        const unsigned x = xb_xcc_id();
        unsigned nloc = st[0], nx = st[1];
        if (nloc == 0u) { xcd_barrier_complete(bar, x, nloc, nx); st[0] = nloc; st[1] = nx; }
        const unsigned old = xb_add(&bar[XB_XSUB(x)], 1u);
        const unsigned gen = old / nloc;
        if (old + 1u == (gen + 1u) * nloc) {
            __builtin_amdgcn_fence(__ATOMIC_RELEASE, "agent");
            asm volatile("s_waitcnt vmcnt(0)" ::: "memory");
            const unsigned og = xb_add(&bar[XB_TOP], 1u);
            const unsigned tg = og / nx;
            if (og + 1u == (tg + 1u) * nx) xb_add(&bar[XB_TOPGEN], 1u);
            else XB_SPIN(xb_ld(&bar[XB_TOPGEN]) == tg, bar);
            __builtin_amdgcn_fence(__ATOMIC_ACQUIRE, "agent");
            xb_add(&bar[XB_XGEN(x)], 1u);
            asm volatile("s_waitcnt vmcnt(0)" ::: "memory");
        } else {
            XB_SPIN(xb_ld(&bar[XB_XGEN(x)]) == gen, bar);
            __builtin_amdgcn_fence(__ATOMIC_ACQUIRE, "agent");
            asm volatile("s_waitcnt vmcnt(0)" ::: "memory");
        }
    }
    __syncthreads();
}

#define LAUNDER_S(p) asm volatile("" : "+s"(p))
__device__ __forceinline__ int opaque_idx(int k) { asm volatile("" : "+s"(k)); return k; }
#define AIN(k) (a.in[opaque_idx(k)])
__global__ void __launch_bounds__(512, 2) mk_fwd(Args a) {
    __shared__ __attribute__((aligned(16))) unsigned char lds_raw[LDS_BYTES];
    LAS unsigned char* lds = (LAS unsigned char*)lds_raw;
    volatile LAS unsigned* bst = (volatile LAS unsigned*)(lds + MISC_OFF);
    if (threadIdx.x < 2) bst[threadIdx.x] = 0u;
    __syncthreads();
    if (a.ph_hi - a.ph_lo > 1 && threadIdx.x == 0) (void)xb_add((unsigned*)a.ws + XB_XCNT(xb_xcc_id()), 1u);
#ifndef PROBE_REPS
#define PROBE_REPS 0
#define PROBE_PHASE 0
#endif
    const int hi = a.ph_hi + PROBE_REPS;
#pragma unroll 1
    for (int q = a.ph_lo; q < hi; ++q) {
        const bool probe = PROBE_REPS > 0 && q >= NPH;
        const int p = probe ? PROBE_PHASE : q;
        const int l = p / 7, k = p - 7 * l;
        int G = gridDim.x, bx = blockIdx.x; LAUNDER_S(G); LAUNDER_S(bx);
        unsigned char* ws = a.ws; LAUNDER_S(ws);
        float* SSQ = (float*)(ws + WS_SSQ);
        if (p == 7 * DEPTH) {
            if (PH_MASK & 128) {
                int tid_ = threadIdx.x; OPAQUE(tid_);
                const int lane = tid_ & 63, gw = bx * 8 + (tid_ >> 6), NGW = G * 8;
                const float* gf = AIN(18); const bf16_t* XB = (const bf16_t*)(ws + WS_XB);
                f32x4 g4[2][2];
#pragma unroll
                for (int j = 0; j < 2; ++j) { g4[j][0] = *(const GAS f32x4*)(gf + 8 * lane + 512 * j); g4[j][1] = *(const GAS f32x4*)(gf + 8 * lane + 512 * j + 4); }
                for (int m = gw; m < M; m += NGW) {
                    const u32x4 w0 = *(const GAS u32x4*)(XB + (size_t)m * D + 8 * lane), w1 = *(const GAS u32x4*)(XB + (size_t)m * D + 8 * lane + 512);
                    const float rs = row_rs(SSQ, m);
                    float* o = a.out + (size_t)m * D + 8 * lane;
                    *(GAS f32x4*)(o) = pg8::bfx4_lo(w0) * rs * g4[0][0]; *(GAS f32x4*)(o + 4) = pg8::bfx4_hi(w0) * rs * g4[0][1];
                    *(GAS f32x4*)(o + 512) = pg8::bfx4_lo(w1) * rs * g4[1][0]; *(GAS f32x4*)(o + 516) = pg8::bfx4_hi(w1) * rs * g4[1][1];
                }
            }
        } else if (k == 0) {
            if (PH_MASK & 1) {
                int tid_ = threadIdx.x; OPAQUE(tid_);
                const int lane = tid_ & 63, wave = __builtin_amdgcn_readfirstlane(tid_ >> 6), gw = bx * 8 + wave, NGW = G * 8;
                bf16_t* WIN = (bf16_t*)(ws + WS_WIN); bf16_t* WA = (bf16_t*)(ws + WS_WA); bf16_t* WB = (bf16_t*)(ws + WS_WB); bf16_t* WP = (bf16_t*)(ws + WS_WP);
                bf16_t* WO = (bf16_t*)(ws + WS_WO); bf16_t* W1 = (bf16_t*)(ws + WS_W1); bf16_t* W2 = (bf16_t*)(ws + ((l & 1) ? WS_W2B : WS_W2)); bf16_t* XB = (bf16_t*)(ws + WS_XB);
                LAS float* scr = (LAS float*)(lds + wave * 16384);
                const float* g_mix = AIN(1) + (size_t)l * D; const float* w_in = AIN(2) + (size_t)l * D * PIN;
                const float* w_a = AIN(5) + (size_t)l * D * D; const float* w_b = AIN(10) + (size_t)l * D * D; const float* w_p = AIN(12) + (size_t)l * 4 * 65536;
                const float* w_o = AIN(14) + (size_t)l * D * D; const float* g_mlp = AIN(15) + (size_t)l * D; const float* w_1 = AIN(16) + (size_t)l * D * FF; const float* w_2 = AIN(17) + (size_t)l * FF * D;
                constexpr int I_IN = 16 * 288, I_SQ = 16 * 32, I_P = 128, I_1 = 16 * 128, I_2 = 64 * 32, NITEMS = I_IN + 3 * I_SQ + I_P + I_1 + I_2;
                for (int it = gw; it < NITEMS; it += NGW) {
                    int r = it;
                    if (r < I_IN) { const int kb = r / 288, nb = r - kb * 288; tr_item(w_in, PIN, g_mix, WIN, D, kb * 64, nb * 32, win_row(nb * 32), scr, lane); continue; } r -= I_IN;
                    if (r < I_SQ) { tr_item(w_a, D, nullptr, WA, D, (r >> 5) * 64, (r & 31) * 32, (r & 31) * 32, scr, lane); continue; } r -= I_SQ;
                    if (r < I_SQ) { tr_item(w_b, D, nullptr, WB, D, (r >> 5) * 64, (r & 31) * 32, (r & 31) * 32, scr, lane); continue; } r -= I_SQ;
                    if (r < I_SQ) { tr_item(w_o, D, nullptr, WO, D, (r >> 5) * 64, (r & 31) * 32, (r & 31) * 32, scr, lane); continue; } r -= I_SQ;
                    if (r < I_P) { const int gi = r >> 5, kb = (r & 31) >> 3, nb = r & 7; tr_item(w_p + (size_t)gi * 65536, 256, nullptr, WP, D, kb * 64, nb * 32, gi * 256 + nb * 32, scr, lane, AIN(13) + (size_t)l * D + gi * 256 + nb * 32); continue; } r -= I_P;
                    if (r < I_1) { const int kb = r >> 7, nb = r & 127; tr_item(w_1, FF, g_mlp, W1, D, kb * 64, nb * 32, nb * 32, scr, lane); continue; } r -= I_1;
                    { const int kb = r >> 5, nb = r & 31; tr_item(w_2, D, nullptr, W2, FF, kb * 64, nb * 32, nb * 32, scr, lane); }
                }
                if (l == 0) {
                    const float* x = AIN(0);
                    for (int m = gw; m < M; m += NGW) {
                        const f32x4* xr = (const f32x4*)(x + (size_t)m * D) + lane; f32x4 v[4]; float s = 0.f;
#pragma unroll
                        for (int j = 0; j < 4; ++j) { v[j] = xr[64 * j]; s += (v[j][0] * v[j][0] + v[j][1] * v[j][1]) + (v[j][2] * v[j][2] + v[j][3] * v[j][3]); }
                        s = wave_sum(s, lane);
                        unsigned long long* o8 = (unsigned long long*)(XB + (size_t)m * D) + lane;
#pragma unroll
                        for (int j = 0; j < 4; ++j) o8[64 * j] = (unsigned long long)cvt_pk_bf16(v[j][0], v[j][1]) | ((unsigned long long)cvt_pk_bf16(v[j][2], v[j][3]) << 32);
                        if (lane < 16) SSQ[(size_t)m * 16 + lane] = lane == 0 ? s : 0.f;
                    }
                }
                __syncthreads();
            }
        } else if (k == 1) {
            if (PH_MASK & 2) {
                pg8::SchedPlain S; S.T.init(M, 6144, G, bx); S.A = (const char*)(ws + WS_XB); S.B = (const char*)(ws + WS_WIN); S.atile = (size_t)256 * D * 2; S.btile = (size_t)256 * D * 2; S.nt = D / 64;
                LAS float* rsl = (LAS float*)(lds + RING_BYTES);
                { pg8::Unit t; for (int j = 0; j < pg8::RS_MAX_ORD && S.next(j, t); ++j) pg8::rs_table_fill(rsl, j, t.pm, SSQ); }
                __syncthreads();
                pg8::EpiG1 E{ws, AIN(3) + (size_t)l * PIN, SSQ, rsl};
                pg8::gemm_phase(lds, pg8::Gemm{D, D}, S, E);
            }
        } else if (k == 2) {
            if (PH_MASK & 4) e_phase(lds, a, ws, l, G);
        } else if (k == 3) {
            if (PH_MASK & 8) {
                pg8::SchedG2 S; S.T.init(M, D, G, bx); S.ws = (const char*)ws;
                LAS float* rsl = (LAS float*)(lds + RING_BYTES);
                { int pm, pn; for (int j = 0; j < pg8::RS_MAX_ORD && S.T.tile(j, pm, pn); ++j) pg8::rs_table_fill(rsl, j, pm, SSQ); }
                __syncthreads();
                pg8::EpiG2 E{ws, AIN(3) + (size_t)l * PIN + 6144, AIN(11) + (size_t)l * D, AIN(13) + (size_t)l * D, SSQ, rsl};
                pg8::gemm_phase(lds, pg8::Gemm{D, D}, S, E);
            }
        } else if (k == 4) {
            if (PH_MASK & 16) {
                pg8::SchedPlain S; S.T.init(M, D, G, bx); S.A = (const char*)(ws + WS_MRG); S.B = (const char*)(ws + WS_WO); S.atile = (size_t)256 * D * 2; S.btile = (size_t)256 * D * 2; S.nt = D / 64;
                pg8::EpiX E{(bf16_t*)(ws + (probe ? WS_PB : WS_XB)), SSQ};
                pg8::gemm_phase(lds, pg8::Gemm{D, D}, S, E);
            }
        } else if (k == 5) {
            if (PH_MASK & 32) {
                pg8::SchedPlain S; S.T.init(M, FF, G, bx); S.A = (const char*)(ws + WS_XB); S.B = (const char*)(ws + WS_W1); S.atile = (size_t)256 * D * 2; S.btile = (size_t)256 * D * 2; S.nt = D / 64;
                LAS float* rsl = (LAS float*)(lds + RING_BYTES);
                { pg8::Unit t; for (int j = 0; j < pg8::RS_MAX_ORD && S.next(j, t); ++j) pg8::rs_table_fill(rsl, j, t.pm, SSQ); }
                __syncthreads();
                pg8::EpiG4 E{(bf16_t*)(ws + WS_HID), SSQ, rsl};
                pg8::gemm_phase(lds, pg8::Gemm{D, D}, S, E);
            }
        } else {
            if (PH_MASK & 64) {
                pg8::SchedPlain S; S.T.init(M, D, G, bx); S.A = (const char*)(ws + WS_HID); S.B = (const char*)(ws + ((l & 1) ? WS_W2B : WS_W2)); S.atile = (size_t)256 * FF * 2; S.btile = (size_t)256 * FF * 2; S.nt = FF / 64;
                pg8::EpiX E{(bf16_t*)(ws + (probe ? WS_PB : WS_XB)), SSQ};
                pg8::gemm_phase(lds, pg8::Gemm{FF, FF}, S, E);
            }
        }
        const bool seam_free = !probe && k == 6 && q + 1 < NPH && (q + 1) < 7 * DEPTH;
        if (q + 1 < hi && !seam_free) { if (a.ph_lo < 0) cg::this_grid().sync(); else xcd_barrier((unsigned*)a.ws, bst); }
    }
}


#ifdef DUMP_AFTER
__global__ void dump_k(const unsigned char* ws, float* out, int which) {
    const size_t n = (size_t)M * D; const bf16_t* b0 = (const bf16_t*)(ws + WS_PA); const bf16_t* b1 = (const bf16_t*)(ws + WS_PB); const bf16_t* b2 = (const bf16_t*)(ws + WS_PC);
    const bf16_t* sc = (const bf16_t*)(ws + WS_MRG); const bf16_t* xb = (const bf16_t*)(ws + WS_XB);
    for (size_t i = blockIdx.x * (size_t)blockDim.x + threadIdx.x; i < n; i += (size_t)gridDim.x * blockDim.x) {
        float v;
        if (which == 1) v = __uint_as_float((unsigned)b0[i] << 16) + 2.f * __uint_as_float((unsigned)((const bf16_t*)(ws + WS_CA))[i] << 16) + 4.f * __uint_as_float((unsigned)((const bf16_t*)(ws + WS_U))[i] << 16) + 8.f * __uint_as_float((unsigned)((const bf16_t*)(ws + WS_CIN))[i] << 16);
        else if (which == 2) v = __uint_as_float((unsigned)b0[i] << 16) + 2.f * __uint_as_float((unsigned)b1[i] << 16) + 4.f * __uint_as_float((unsigned)b2[i] << 16);
        else if (which == 3) v = __uint_as_float((unsigned)sc[i] << 16);
        else v = __uint_as_float((unsigned)xb[i] << 16);
        out[i] = v;
    }
}
#endif
extern "C" void kernel_launch(void* const* d_in, const int* in_sizes, int n_in, void* d_out, int out_size, void* d_ws, size_t ws_size, hipStream_t stream) {
    static int grid = 0;
    if (grid == 0) {
        if (n_in != 19 || in_sizes[0] != M * D || out_size != M * D || ws_size < WS_END) { fprintf(stderr, "kernel_launch: unexpected shapes (n_in %d, in0 %d, out %d, ws %zu)\n", n_in, n_in > 0 ? in_sizes[0] : -1, out_size, ws_size); grid = -1; return; }
        int dev = 0, cus = 0, per_cu = 0;
        if (hipGetDevice(&dev) != hipSuccess || hipDeviceGetAttribute(&cus, hipDeviceAttributeMultiprocessorCount, dev) != hipSuccess) { grid = -1; return; }
        if (hipOccupancyMaxActiveBlocksPerMultiprocessor(&per_cu, (const void*)mk_fwd, 512, 0) != hipSuccess || per_cu < 1) { fprintf(stderr, "kernel_launch: occupancy query says %d\n", per_cu); per_cu = 1; }
        (void)hipGetLastError();
        grid = cus * 1;
    }
    if (grid < 0) return;
    Args a{};
    for (int i = 0; i < 19; ++i) a.in[i] = (const float*)d_in[i];
    a.out = (float*)d_out; a.ws = (unsigned char*)d_ws;
#if MK_N_LAUNCHES == 1
    if (hipMemsetAsync(d_ws, 0, 16384, stream) != hipSuccess) { fprintf(stderr, "kernel_launch: memset of the barrier words failed\n"); return; }
    a.ph_lo = 0; a.ph_hi = NPH;
    void* args[] = {&a};
    hipError_t e = hipLaunchCooperativeKernel((const void*)mk_fwd, dim3(grid), dim3(512), args, 0, stream);
    if (e != hipSuccess) fprintf(stderr, "kernel_launch: cooperative launch failed: %s (grid %d)\n", hipGetErrorString(e), grid);
#else
#ifdef DUMP_AFTER
    for (int p = 0; p <= DUMP_AFTER; ++p) { a.ph_lo = p; a.ph_hi = p + 1; hipLaunchKernelGGL(mk_fwd, dim3(grid), dim3(512), 0, stream, a); }
    hipLaunchKernelGGL(dump_k, dim3(2048), dim3(256), 0, stream, (const unsigned char*)d_ws, (float*)d_out, (int)DUMP_AFTER);
#else
    for (int p = 0; p < NPH; ++p) { a.ph_lo = p; a.ph_hi = p + 1; hipLaunchKernelGGL(mk_fwd, dim3(grid), dim3(512), 0, stream, a); }
#endif
#endif
}
```

```cpp
#include <hip/hip_runtime.h>
#include <hip/hip_cooperative_groups.h>
#include <cstdio>
#include <cstdint>
namespace cg = cooperative_groups;

#ifndef PH_MASK
#define PH_MASK 0xff
#endif
#ifndef MK_N_LAUNCHES
#define MK_N_LAUNCHES 1
#endif

#define LAS __attribute__((address_space(3)))
typedef unsigned short bf16_t;
typedef short bf16x8 __attribute__((ext_vector_type(8)));
typedef float f32x4 __attribute__((ext_vector_type(4)));
typedef float f32x2 __attribute__((ext_vector_type(2)));
typedef unsigned u32x4 __attribute__((ext_vector_type(4)));

constexpr int M = 16384, D = 1024, SEQ = 8192, PIN = 9216, FF = 4096, DEPTH = 2;
constexpr float EPS = 1e-6f;
constexpr int NPH = 7 * DEPTH + 1;

constexpr size_t MiB = 1u << 20;
constexpr size_t WS_WIN = 1 * MiB, WS_WA = 19 * MiB, WS_WB = 21 * MiB, WS_WP = 23 * MiB, WS_WO = 25 * MiB, WS_W1 = 27 * MiB, WS_W2 = 35 * MiB, WS_SSQ = 43 * MiB;
constexpr size_t WS_XB = 44 * MiB, WS_PA = 76 * MiB, WS_CA = 108 * MiB, WS_U = 140 * MiB, WS_CIN = 172 * MiB, WS_PB = 204 * MiB, WS_PC = 236 * MiB, WS_W2B = 268 * MiB, WS_END = 276 * MiB;
constexpr size_t WS_HID = WS_PA;
constexpr size_t WS_GQ0 = WS_CA, WS_GQ1 = WS_CA + 16 * MiB, WS_GQ2 = WS_U;
constexpr size_t WS_MRG = WS_CIN;
static_assert(WS_HID + (size_t)M * FF * 2 <= WS_PB && WS_GQ2 + (size_t)M * D <= WS_CIN && WS_MRG + (size_t)M * D * 2 <= WS_PB, "ws map");

constexpr int RING_BYTES = 131072, RS_BYTES = 16384, MISC_OFF = RING_BYTES + RS_BYTES, LDS_BYTES = MISC_OFF + 256;

#define OPAQUE(v) asm volatile("" : "+v"(v))
typedef __bf16 bf16x2_t __attribute__((ext_vector_type(2)));
__device__ __forceinline__ unsigned cvt_pk_bf16(float lo, float hi) { const f32x2 v = {lo, hi}; const bf16x2_t b = __builtin_convertvector(v, bf16x2_t); return __builtin_bit_cast(unsigned, b); }
__device__ __forceinline__ float bf_lo(unsigned w) { return __uint_as_float(w << 16); }
__device__ __forceinline__ float bf_hi(unsigned w) { return __uint_as_float(w & 0xffff0000u); }
__device__ __forceinline__ float sigm(float x) { return __builtin_amdgcn_rcpf(1.0f + __builtin_amdgcn_exp2f(-1.4426950408889634f * x)); }
__device__ __forceinline__ f32x4 sigm4(f32x4 v) { return (f32x4){sigm(v[0]), sigm(v[1]), sigm(v[2]), sigm(v[3])}; }
__device__ __forceinline__ u32x4 pack8(f32x4 a, f32x4 b) { u32x4 w; w.x = cvt_pk_bf16(a[0], a[1]); w.y = cvt_pk_bf16(a[2], a[3]); w.z = cvt_pk_bf16(b[0], b[1]); w.w = cvt_pk_bf16(b[2], b[3]); return w; }
__device__ __forceinline__ float row_rs(const float* ssq, int row) {
    const f32x4* p = (const f32x4*)(ssq + (size_t)row * 16); const f32x4 a = p[0], b = p[1], c = p[2], d = p[3];
    const float s = ((a[0] + a[1]) + (a[2] + a[3])) + ((b[0] + b[1]) + (b[2] + b[3])) + ((c[0] + c[1]) + (c[2] + c[3])) + ((d[0] + d[1]) + (d[2] + d[3]));
    return rsqrtf(s * (1.0f / D) + EPS);
}
__device__ __forceinline__ float shx(float v, int mask, int lane) { return __builtin_bit_cast(float, __builtin_amdgcn_ds_bpermute((lane ^ mask) << 2, __builtin_bit_cast(int, v))); }
__device__ __forceinline__ float wave_sum(float v, int lane) {
#pragma unroll
    for (int o = 1; o < 64; o <<= 1) v += shx(v, o, lane);
    return v;
}

namespace pg8 {
constexpr int BM = 256, BK = 64, HALF = 128, HTB = HALF * BK * 2, NXCD = 8, WGM = 4;
__host__ __device__ __forceinline__ int lds_byte(int r, int c) { const int st = (r >> 4) * 2 + (c >> 5), rr = r & 15, cc = c & 31, ob = rr * 64 + cc * 2; return st * 1024 + (ob ^ (((ob >> 9) & 1) << 5)); }
__host__ __device__ __forceinline__ void stage_rc(int b, int& R, int& C) { const int st = b / 1024, sb = b % 1024, swz = sb ^ (((sb >> 9) & 1) << 5); R = (st >> 1) * 16 + swz / 64; C = (st & 1) * 32 + (swz % 64) / 2; }
__host__ __device__ __forceinline__ int perm32(int rho) { const int n = rho >> 4, i = rho & 15; return 8 * (i >> 2) + 4 * n + (i & 3); }

struct Unit { int pm, pn, kind, nt, ord, n0, n1; const char* A; const char* B; const char* A1; const char* B1; const char* A2; const char* B2; };
struct Gemm { int lda, ldb; };

struct TileSched {
    int nM, nN, nwg, G, c;
    __device__ void init(int M_, int N_, int G_, int c_) { nM = M_ / BM; nN = N_ / BM; nwg = nM * nN; G = G_; c = c_; }
    __device__ bool tile(int i, int& pm, int& pn) const {
        const long L = (long)i * G + c; if (L >= nwg) return false;
        int wgid = (int)L; { const int q = nwg / NXCD, r = nwg % NXCD, xcd = wgid % NXCD, off = wgid / NXCD; wgid = (xcd < r ? xcd * (q + 1) : r * (q + 1) + (xcd - r) * q) + off; }
        const int nig = WGM * nN, gid = wgid / nig, fm = gid * WGM, gsz = (nM - fm) < WGM ? (nM - fm) : WGM;
        pm = fm + ((wgid % nig) % gsz); pn = (wgid % nig) / gsz; return true;
    }
};
struct SchedPlain {
    TileSched T; const char* A; const char* B; size_t atile, btile; int nt;
    __device__ bool next(int i, Unit& u) const { int pm, pn; if (!T.tile(i, pm, pn)) return false; u.pm = pm; u.pn = pn; u.kind = 0; u.nt = nt; u.ord = i; u.n0 = nt; u.n1 = nt; u.A = A + (size_t)pm * atile; u.B = B + (size_t)pn * btile; return true; }
};
struct SchedG2 {
    TileSched T; const char* ws;
    __device__ bool next(int i, Unit& u) const {
        const int ti = i >> 2, kind = i & 3; int pm, pn; if (!T.tile(ti, pm, pn)) return false;
        const size_t ar = (size_t)pm * (256 * 1024 * 2), br = (size_t)pn * (256 * 1024 * 2);
        u.pm = pm; u.pn = pn; u.kind = kind; u.ord = ti;
        if (kind < 3) { u.nt = 16; u.n0 = 16; u.n1 = 16; u.A = ws + WS_XB + ar; u.B = ws + WS_WIN + (size_t)6144 * 2048 + (size_t)kind * (1024 * 1024 * 2) + br; u.A1 = u.A; u.B1 = u.B; u.A2 = u.A; u.B2 = u.B; }
        else { u.nt = 36; u.n0 = 16; u.n1 = 32; u.A = ws + WS_PA + ar; u.B = ws + WS_WA + br; u.A1 = ws + WS_PB + ar; u.B1 = ws + WS_WB + br; u.A2 = ws + WS_PC + ar + (size_t)pn * 512; u.B2 = ws + WS_WP + br; }
        return true;
    }
};

template <class Epi, class Sched>
__device__ __forceinline__ void gemm_phase(LAS unsigned char* lds, const Gemm g, const Sched& S, const Epi& E) {
    int tid_ = threadIdx.x; OPAQUE(tid_);
    const int tid = tid_, wid = __builtin_amdgcn_readfirstlane(tid >> 6), lane = tid & 63, wr = wid >> 2, wc = wid & 3, fr = lane & 15, fq = lane >> 4;
    unsigned voffA[2], voffB[2];
#pragma unroll
    for (int i = 0; i < 2; ++i) { int R, C; stage_rc(tid * 16 + i * 8192, R, C); const int Rb = (R & ~31) + perm32(R & 31);
        voffA[i] = (unsigned)(R * g.lda + C) * 2u; voffB[i] = (unsigned)(Rb * g.ldb + C) * 2u; }
    const size_t kstep = (size_t)(BK * 2);
    const size_t hstepA = (size_t)HALF * g.lda * 2, hstepB = (size_t)HALF * g.ldb * 2;
    const unsigned ldsw = (unsigned)wid * 1024u;
    const int aoff = lds_byte(wr * 64 + fr, fq * 8), boff = lds_byte(wc * 32 + fr, fq * 8);
#define PG8_SA(b, h) (((b) * 2 + (h)) * HTB)
#define PG8_SB(b, h) ((4 + (b) * 2 + (h)) * HTB)
#define PG8_STAGE(bufoff, gbase, voff) do { _Pragma("unroll") for (int _i = 0; _i < 2; ++_i) \
        __builtin_amdgcn_global_load_lds((const unsigned*)((const char*)(gbase) + (voff)[_i]), (LAS unsigned*)(lds + (bufoff) + ldsw + _i * 8192), 16, 0, 0); } while (0)
#define PG8_LDA(dst, b, h) do { _Pragma("unroll") for (int m = 0; m < 4; ++m) _Pragma("unroll") for (int k = 0; k < 2; ++k) dst[m][k] = *(const LAS bf16x8*)(lds + PG8_SA(b, h) + aoff + m * 2048 + k * 1024); } while (0)
#define PG8_LDB(dst, b, h) do { _Pragma("unroll") for (int n = 0; n < 2; ++n) _Pragma("unroll") for (int k = 0; k < 2; ++k) dst[n][k] = *(const LAS bf16x8*)(lds + PG8_SB(b, h) + boff + n * 2048 + k * 1024); } while (0)
#define PG8_MMA(ai, bj, At, Bt) do { __builtin_amdgcn_s_setprio(1); _Pragma("unroll") for (int m = 0; m < 4; ++m) _Pragma("unroll") for (int n = 0; n < 2; ++n) _Pragma("unroll") for (int k = 0; k < 2; ++k) \
        acc[ai][bj][m][n] = __builtin_amdgcn_mfma_f32_16x16x32_bf16(Bt[n][k], At[m][k], acc[ai][bj][m][n], 0, 0, 0); __builtin_amdgcn_s_setprio(0); } while (0)
#define PG8_WAIT_V(n) asm volatile("s_waitcnt vmcnt(" #n ")" ::: "memory")
#define PG8_WAIT_L(n) asm volatile("s_waitcnt lgkmcnt(" #n ")" ::: "memory")
#define PG8_BAR __builtin_amdgcn_s_barrier()
#define PG8_SCHED __builtin_amdgcn_sched_barrier(0)
    Unit cur, nxt; int ui = 0;
    if (!S.next(0, cur)) return;
    f32x4 acc[2][2][4][2];
#pragma unroll
    for (int a = 0; a < 2; ++a)
#pragma unroll
        for (int b = 0; b < 2; ++b)
#pragma unroll
            for (int m = 0; m < 4; ++m)
#pragma unroll
                for (int n = 0; n < 2; ++n) acc[a][b][m][n] = (f32x4){0.f, 0.f, 0.f, 0.f};
    bf16x8 At[4][2], B0[2][2], B1[2][2];
    const char* cA = cur.A; const char* cB = cur.B;
    PG8_STAGE(PG8_SB(0, 0), cB, voffB); PG8_STAGE(PG8_SB(0, 1), cB + hstepB, voffB); PG8_STAGE(PG8_SA(0, 0), cA, voffA); PG8_STAGE(PG8_SA(0, 1), cA + hstepA, voffA);
    if (wr == 1) PG8_BAR;
    PG8_WAIT_V(2); PG8_BAR;
    PG8_STAGE(PG8_SB(1, 0), cB + kstep, voffB); PG8_STAGE(PG8_SA(1, 0), cA + kstep, voffA); PG8_STAGE(PG8_SB(1, 1), cB + hstepB + kstep, voffB);
    PG8_WAIT_V(6); PG8_BAR;
    for (;;) {
        const bool has_next = S.next(ui + 1, nxt);
        const char* nA = has_next ? nxt.A : cA; const char* nB = has_next ? nxt.B : cB;
        const int nt = cur.nt;
        for (int t = 0; t < nt; t += 2) {
            const bool last = (t == nt - 2);
            const char *a1, *a2, *b2;
            if constexpr (Epi::HAS_MID) {
                const int t2 = t + 2;
                a1 = (t < cur.n0 ? cur.A + (size_t)t * kstep : (t < cur.n1 ? cur.A1 + (size_t)(t - cur.n0) * kstep : cur.A2 + (size_t)(t - cur.n1) * kstep)) + kstep;
                a2 = last ? nA : (t2 < cur.n0 ? cur.A + (size_t)t2 * kstep : (t2 < cur.n1 ? cur.A1 + (size_t)(t2 - cur.n0) * kstep : cur.A2 + (size_t)(t2 - cur.n1) * kstep));
                b2 = last ? nB : (t2 < cur.n0 ? cur.B + (size_t)t2 * kstep : (t2 < cur.n1 ? cur.B1 + (size_t)(t2 - cur.n0) * kstep : cur.B2 + (size_t)(t2 - cur.n1) * kstep));
            } else {
                a1 = cA + (size_t)(t + 1) * kstep;
                a2 = last ? nA : cA + (size_t)(t + 2) * kstep; b2 = last ? nB : cB + (size_t)(t + 2) * kstep;
            }
            const char* a3 = a2 + kstep; const char* b3 = b2 + kstep;
            PG8_LDB(B0, 0, 0); PG8_LDB(B1, 0, 1); PG8_SCHED; PG8_LDA(At, 0, 0); PG8_STAGE(PG8_SA(1, 1), a1 + hstepA, voffA);
            PG8_WAIT_V(8); PG8_WAIT_L(0); PG8_BAR; PG8_MMA(0, 0, At, B0); PG8_MMA(0, 1, At, B1); PG8_BAR; PG8_SCHED;
            PG8_LDA(At, 0, 1); PG8_STAGE(PG8_SB(0, 0), b2, voffB); PG8_STAGE(PG8_SB(0, 1), b2 + hstepB, voffB); PG8_STAGE(PG8_SA(0, 0), a2, voffA);
            PG8_WAIT_V(8); PG8_WAIT_L(0); PG8_BAR; PG8_MMA(1, 0, At, B0); PG8_MMA(1, 1, At, B1); PG8_BAR; PG8_SCHED;
            PG8_LDB(B0, 1, 0); PG8_LDB(B1, 1, 1); PG8_SCHED; PG8_LDA(At, 1, 0); PG8_STAGE(PG8_SA(0, 1), a2 + hstepA, voffA);
            PG8_WAIT_V(8); PG8_WAIT_L(0); PG8_BAR; PG8_MMA(0, 0, At, B0); PG8_MMA(0, 1, At, B1); PG8_BAR; PG8_SCHED;
            PG8_LDA(At, 1, 1); PG8_STAGE(PG8_SB(1, 0), b3, voffB); PG8_STAGE(PG8_SB(1, 1), b3 + hstepB, voffB); PG8_STAGE(PG8_SA(1, 0), a3, voffA);
            PG8_WAIT_V(8); PG8_WAIT_L(0); PG8_BAR; PG8_MMA(1, 0, At, B0); PG8_MMA(1, 1, At, B1); PG8_BAR; PG8_SCHED;
            if constexpr (Epi::HAS_MID) {
                if (t + 2 < nt && (t + 2 == cur.n0 || t + 2 == cur.n1)) { E.mid(acc, cur, t + 2 == cur.n0 ? 0 : 1, wr, wc, fr, fq); PG8_SCHED; }
            }
        }
        if (wr == 0) PG8_BAR;
        E(acc, cur, wr, wc, fr, fq);
        if (!has_next) break;
#pragma unroll
        for (int a = 0; a < 2; ++a)
#pragma unroll
            for (int b = 0; b < 2; ++b)
#pragma unroll
                for (int m = 0; m < 4; ++m)
#pragma unroll
                    for (int n = 0; n < 2; ++n) acc[a][b][m][n] = (f32x4){0.f, 0.f, 0.f, 0.f};
        cur = nxt; cA = nA; cB = nB; ++ui;
        if (wr == 1) PG8_BAR;
    }
    PG8_WAIT_V(0);
    PG8_BAR;
#undef PG8_SA
#undef PG8_SB
#undef PG8_STAGE
#undef PG8_LDA
#undef PG8_LDB
#undef PG8_MMA
#undef PG8_WAIT_V
#undef PG8_WAIT_L
#undef PG8_BAR
#undef PG8_SCHED
}

typedef f32x4 Acc[2][2][4][2];
#define GAS __attribute__((address_space(1)))
__device__ __forceinline__ f32x4 ldg4f(const float* p) { return *(const GAS f32x4*)p; }
__device__ __forceinline__ u32x4 ldg4u(const void* p) { return *(const GAS u32x4*)p; }
__device__ __forceinline__ void stg4f(float* p, f32x4 v) { *(GAS f32x4*)p = v; }
__device__ __forceinline__ void stg4u(void* p, u32x4 v) { *(GAS u32x4*)p = v; }
__device__ __forceinline__ f32x4 bfx4_lo(u32x4 w) { return (f32x4){bf_lo(w.x), bf_hi(w.x), bf_lo(w.y), bf_hi(w.y)}; }
__device__ __forceinline__ f32x4 bfx4_hi(u32x4 w) { return (f32x4){bf_lo(w.z), bf_hi(w.z), bf_lo(w.w), bf_hi(w.w)}; }

constexpr int RS_MAX_ORD = 16;
__device__ __forceinline__ void rs_table_fill(LAS float* rsl, int ord, int pm, const float* ssq) {
    int t_ = threadIdx.x; OPAQUE(t_); const int t = t_, r = t >> 1, h = t & 1;
    const float* p = ssq + (size_t)(pm * BM + r) * 16 + h * 8; const f32x4 a = ldg4f(p), b = ldg4f(p + 4);
    float s = ((a[0] + a[1]) + (a[2] + a[3])) + ((b[0] + b[1]) + (b[2] + b[3]));
    s += shx(s, 1, t & 63);
    if (h == 0) rsl[ord * BM + r] = rsqrtf(s * (1.0f / D) + EPS);
}
__device__ __forceinline__ float rs_get(const LAS float* rsl, const float* ssq, int ord, int lrow, int row) { return ord < RS_MAX_ORD ? rsl[ord * BM + lrow] : row_rs(ssq, row); }

struct EpiG1 {
    static constexpr bool HAS_MID = false;
    unsigned char* ws; const float* b_in; const float* ssq; const LAS float* rsl;
    __device__ __forceinline__ void operator()(const Acc& acc, const Unit& u, int wr, int wc, int fr, int fq) const {
        const int lrow0 = wr * 64 + fr, row0 = u.pm * BM + lrow0, cc = wc * 32 + 8 * fq, pn = u.pn;
        float rs[2][4];
#pragma unroll
        for (int ai = 0; ai < 2; ++ai)
#pragma unroll
            for (int m = 0; m < 4; ++m) rs[ai][m] = rs_get(rsl, ssq, u.ord, lrow0 + ai * HALF + m * 16, row0 + ai * HALF + m * 16);
        if (pn < 4 || pn >= 20) {
            bf16_t* dst = (bf16_t*)(ws + (pn < 4 ? WS_PA : WS_CIN)); const int cb = (pn < 4 ? pn : pn - 20) * 256; const float* bs = b_in + (pn < 4 ? 0 : 5120) + cb + cc;
            f32x4 bv[2][2];
#pragma unroll
            for (int bj = 0; bj < 2; ++bj)
#pragma unroll
                for (int n = 0; n < 2; ++n) bv[bj][n] = ldg4f(bs + bj * HALF + 4 * n);
#pragma unroll
            for (int ai = 0; ai < 2; ++ai)
#pragma unroll
                for (int m = 0; m < 4; ++m) { const int row = row0 + ai * HALF + m * 16; const float r = rs[ai][m]; bf16_t* rowp = dst + (size_t)row * D + cb + cc;
#pragma unroll
                    for (int bj = 0; bj < 2; ++bj) stg4u(rowp + bj * HALF, pack8(acc[ai][bj][m][0] * r + bv[bj][0], acc[ai][bj][m][1] * r + bv[bj][1])); }
        } else {
            const bool glu = pn >= 12; const int q = glu ? pn - 12 : pn - 4; const int col = q * 128 + cc;
            bf16_t* dst = (bf16_t*)(ws + (glu ? WS_U : WS_CA)); const float* b0 = b_in + (glu ? 3072 : 1024) + col; const float* b1 = b0 + 1024;
            f32x4 bv[2][2];
#pragma unroll
            for (int n = 0; n < 2; ++n) { bv[0][n] = ldg4f(b0 + 4 * n); bv[1][n] = ldg4f(b1 + 4 * n); }
#pragma unroll
            for (int ai = 0; ai < 2; ++ai)
#pragma unroll
                for (int m = 0; m < 4; ++m) { const int row = row0 + ai * HALF + m * 16; const float r = rs[ai][m];
                    f32x4 p0 = acc[ai][0][m][0] * r + bv[0][0], p1 = acc[ai][0][m][1] * r + bv[0][1], q0 = acc[ai][1][m][0] * r + bv[1][0], q1 = acc[ai][1][m][1] * r + bv[1][1];
                    if (glu) { q0 = sigm4(q0); q1 = sigm4(q1); }
                    stg4u(dst + (size_t)row * D + col, pack8(p0 * q0, p1 * q1)); }
        }
    }
};

typedef unsigned u32x2 __attribute__((ext_vector_type(2)));
__device__ __forceinline__ unsigned pack_q4(f32x4 g) {
    const f32x4 t = g * 255.0f + 0.5f; unsigned w = 0u;
    w = __builtin_amdgcn_cvt_pk_u8_f32(t[0], 0, w); w = __builtin_amdgcn_cvt_pk_u8_f32(t[1], 1, w); w = __builtin_amdgcn_cvt_pk_u8_f32(t[2], 2, w); w = __builtin_amdgcn_cvt_pk_u8_f32(t[3], 3, w); return w;
}
__device__ __forceinline__ f32x4 dec_q4(unsigned w) {
    const f32x4 q = (f32x4){(float)(w & 0xffu), (float)((w >> 8) & 0xffu), (float)((w >> 16) & 0xffu), (float)(w >> 24)};
    return __builtin_elementwise_max(q, (f32x4){0.5f, 0.5f, 0.5f, 0.5f}) * (1.0f / 255.0f);
}
__device__ __forceinline__ f32x4 rcp4(f32x4 v) { return (f32x4){__builtin_amdgcn_rcpf(v[0]), __builtin_amdgcn_rcpf(v[1]), __builtin_amdgcn_rcpf(v[2]), __builtin_amdgcn_rcpf(v[3])}; }
struct EpiG2 {
    static constexpr bool HAS_MID = true;
    unsigned char* ws; const float* bg; const float* bb; const float* scale; const float* ssq; const LAS float* rsl;
    __device__ __forceinline__ void mid(Acc& acc, const Unit& u, int which, int wr, int wc, int fr, int fq) const {
        const int row0 = u.pm * BM + wr * 64 + fr, cc = u.pn * BM + wc * 32 + 8 * fq;
        const size_t base = (size_t)row0 * D + cc;
        const unsigned char* GN = ws + (which == 0 ? WS_GQ0 : WS_GQ1); const unsigned char* GD = ws + (which == 0 ? WS_GQ1 : WS_GQ2);
        f32x4 bv[2][2];
#pragma unroll
        for (int bj = 0; bj < 2; ++bj)
#pragma unroll
            for (int n = 0; n < 2; ++n) bv[bj][n] = which ? ldg4f(bb + cc + bj * HALF + 4 * n) : (f32x4){0.f, 0.f, 0.f, 0.f};
#pragma unroll
        for (int ai = 0; ai < 2; ++ai) {
            u32x2 qn[4][2], qd[4][2];
#pragma unroll
            for (int m = 0; m < 4; ++m)
#pragma unroll
                for (int bj = 0; bj < 2; ++bj) { const size_t off = base + (size_t)(ai * HALF + m * 16) * D + bj * HALF; qn[m][bj] = *(const GAS u32x2*)(GN + off); qd[m][bj] = *(const GAS u32x2*)(GD + off); }
#pragma unroll
            for (int m = 0; m < 4; ++m)
#pragma unroll
                for (int bj = 0; bj < 2; ++bj) {
                    acc[ai][bj][m][0] = (acc[ai][bj][m][0] + bv[bj][0]) * dec_q4(qn[m][bj].x) * rcp4(dec_q4(qd[m][bj].x));
                    acc[ai][bj][m][1] = (acc[ai][bj][m][1] + bv[bj][1]) * dec_q4(qn[m][bj].y) * rcp4(dec_q4(qd[m][bj].y)); }
        }
    }
    __device__ __forceinline__ void operator()(const Acc& acc, const Unit& u, int wr, int wc, int fr, int fq) const {
        const int lrow0 = wr * 64 + fr, row0 = u.pm * BM + lrow0, cc = u.pn * BM + wc * 32 + 8 * fq, kind = u.kind;
        const size_t base = (size_t)row0 * D + cc;
        if (kind < 3) {
            unsigned char* GQ = ws + (kind == 0 ? WS_GQ0 : (kind == 1 ? WS_GQ1 : WS_GQ2));
            const float* b = bg + kind * 1024 + cc;
            f32x4 bv[2][2];
#pragma unroll
            for (int bj = 0; bj < 2; ++bj)
#pragma unroll
                for (int n = 0; n < 2; ++n) bv[bj][n] = ldg4f(b + bj * HALF + 4 * n);
#pragma unroll
            for (int ai = 0; ai < 2; ++ai)
#pragma unroll
                for (int m = 0; m < 4; ++m) { const float r = rs_get(rsl, ssq, u.ord, lrow0 + ai * HALF + m * 16, row0 + ai * HALF + m * 16);
#pragma unroll
                    for (int bj = 0; bj < 2; ++bj) { u32x2 q; q.x = pack_q4(sigm4(acc[ai][bj][m][0] * r + bv[bj][0])); q.y = pack_q4(sigm4(acc[ai][bj][m][1] * r + bv[bj][1]));
                        *(GAS u32x2*)(GQ + base + (size_t)(ai * HALF + m * 16) * D + bj * HALF) = q; } }
        } else {
            const unsigned char* GN = ws + WS_GQ2;
            u32x2 qn[2][4][2];
#pragma unroll
            for (int ai = 0; ai < 2; ++ai)
#pragma unroll
                for (int m = 0; m < 4; ++m)
#pragma unroll
                    for (int bj = 0; bj < 2; ++bj) qn[ai][m][bj] = *(const GAS u32x2*)(GN + base + (size_t)(ai * HALF + m * 16) * D + bj * HALF);
#pragma unroll
            for (int ai = 0; ai < 2; ++ai)
#pragma unroll
                for (int m = 0; m < 4; ++m)
#pragma unroll
                    for (int bj = 0; bj < 2; ++bj) stg4u((bf16_t*)(ws + WS_MRG) + base + (size_t)(ai * HALF + m * 16) * D + bj * HALF,
                        pack8(acc[ai][bj][m][0] * dec_q4(qn[ai][m][bj].x), acc[ai][bj][m][1] * dec_q4(qn[ai][m][bj].y)));
        }
    }
};

struct EpiX {
    static constexpr bool HAS_MID = false;
    bf16_t* XB; float* ssq;
    __device__ __forceinline__ void operator()(const Acc& acc, const Unit& u, int wr, int wc, int fr, int fq) const {
        const int row0 = u.pm * BM + wr * 64 + fr, cc = u.pn * BM + wc * 32 + 8 * fq;
        u32x4 bs[2][4][2];
#pragma unroll
        for (int ai = 0; ai < 2; ++ai)
#pragma unroll
            for (int m = 0; m < 4; ++m)
#pragma unroll
                for (int bj = 0; bj < 2; ++bj) bs[ai][m][bj] = ldg4u(XB + (size_t)(row0 + ai * HALF + m * 16) * D + cc + bj * HALF);
#pragma unroll
        for (int ai = 0; ai < 2; ++ai)
#pragma unroll
            for (int m = 0; m < 4; ++m) { const int row = row0 + ai * HALF + m * 16; float ss = 0.f;
#pragma unroll
                for (int bj = 0; bj < 2; ++bj) { const size_t off = (size_t)row * D + cc + bj * HALF;
                    const f32x4 v0 = bfx4_lo(bs[ai][m][bj]) + acc[ai][bj][m][0], v1 = bfx4_hi(bs[ai][m][bj]) + acc[ai][bj][m][1];
                    stg4u(XB + off, pack8(v0, v1));
                    ss += ((v0[0] * v0[0] + v0[1] * v0[1]) + (v0[2] * v0[2] + v0[3] * v0[3])) + ((v1[0] * v1[0] + v1[1] * v1[1]) + (v1[2] * v1[2] + v1[3] * v1[3])); }
                ss += shx(ss, 16, fq * 16 + (row0 & 15)); ss += shx(ss, 32, fq * 16 + (row0 & 15));
                if (fq == 0) *(GAS float*)(ssq + (size_t)row * 16 + u.pn * 4 + wc) = ss; }
    }
};

struct EpiG4 {
    static constexpr bool HAS_MID = false;
    bf16_t* HID; const float* ssq; const LAS float* rsl;
    __device__ __forceinline__ void operator()(const Acc& acc, const Unit& u, int wr, int wc, int fr, int fq) const {
        const int lrow0 = wr * 64 + fr, row0 = u.pm * BM + lrow0, cc = u.pn * BM + wc * 32 + 8 * fq;
#pragma unroll
        for (int ai = 0; ai < 2; ++ai)
#pragma unroll
            for (int m = 0; m < 4; ++m) { const int row = row0 + ai * HALF + m * 16; const float rs = rs_get(rsl, ssq, u.ord, lrow0 + ai * HALF + m * 16, row);
#pragma unroll
                for (int bj = 0; bj < 2; ++bj) { f32x4 v0 = acc[ai][bj][m][0] * rs, v1 = acc[ai][bj][m][1] * rs;
                    v0 = __builtin_elementwise_max(v0, (f32x4){0.f, 0.f, 0.f, 0.f}); v1 = __builtin_elementwise_max(v1, (f32x4){0.f, 0.f, 0.f, 0.f});
                    stg4u(HID + (size_t)row * FF + cc + bj * HALF, pack8(v0 * v0, v1 * v1)); } }
    }
};
}

__device__ __forceinline__ void tr_item(const float* W, int ldw, const float* gain, bf16_t* WT, int ldd, int k0, int n0, int drow0, LAS float* scr, int lane, const float* ngain = nullptr) {
    float wv[32];
    const float* wp = W + (size_t)(k0 + (lane >> 5)) * ldw + n0 + (lane & 31);
#pragma unroll
    for (int i = 0; i < 32; ++i) wv[i] = *(const GAS float*)(wp + (size_t)(2 * i) * ldw);
    float gv0 = 1.0f;
    if (gain) gv0 = gain[k0 + lane];
#pragma unroll
    for (int i = 0; i < 32; ++i) { const int kk = 2 * i + (lane >> 5); const float gv = gain ? __builtin_bit_cast(float, __builtin_amdgcn_ds_bpermute(kk << 2, __builtin_bit_cast(int, gv0))) : 1.0f; scr[kk * 33 + (lane & 31)] = wv[i] * gv; }
    asm volatile("s_waitcnt lgkmcnt(0)" ::: "memory");
    const int c = lane & 7;
#pragma unroll
    for (int j = 0; j < 4; ++j) { const int n = (lane >> 3) + 8 * j; const LAS float* s = scr + (8 * c) * 33 + n; const float ng = ngain ? ngain[n] : 1.0f;
        u32x4 o; o.x = cvt_pk_bf16(s[0 * 33] * ng, s[1 * 33] * ng); o.y = cvt_pk_bf16(s[2 * 33] * ng, s[3 * 33] * ng); o.z = cvt_pk_bf16(s[4 * 33] * ng, s[5 * 33] * ng); o.w = cvt_pk_bf16(s[6 * 33] * ng, s[7 * 33] * ng);
        *(u32x4*)(WT + (size_t)(drow0 + n) * ldd + k0 + 8 * c) = o; }
    asm volatile("s_waitcnt lgkmcnt(0)" ::: "memory");
}
__device__ __forceinline__ int win_row(int n) {
    if (n < 1024 || n >= 5120) return n;
    const int base = n < 3072 ? 1024 : 3072, j = n - base, which = j >> 10, jj = j & 1023;
    return base + (jj >> 7) * 256 + which * 128 + (jj & 127);
}

struct Args { const float* in[19]; float* out; unsigned char* ws; int ph_lo, ph_hi; };

__device__ __forceinline__ f32x2 unpk(unsigned w) { return (f32x2){bf_lo(w), bf_hi(w)}; }
template <int W>
__device__ __forceinline__ void pool_compute(const unsigned (&raw)[47], GAS char* PCg, unsigned ooff, int t0) {
    constexpr int H = W - 1, B0 = 15 - H;
    f32x2 S = (f32x2){0.f, 0.f};
#pragma unroll
    for (int j = 0; j < H; ++j) S += unpk(raw[B0 + j]);
#pragma unroll
    for (int i = 0; i < 32; ++i) {
        const f32x2 v = unpk(raw[15 + i]);
        S += v;
        const float inv = (t0 > 0 || i + 1 >= W) ? (1.0f / W) : (1.0f / (float)(i + 1));
        const f32x2 o = S * inv - v;
        *(GAS unsigned*)(PCg + ooff) = cvt_pk_bf16(o.x, o.y); ooff += D * 2; OPAQUE(ooff);
        S -= unpk(raw[B0 + i]);
    }
}
__device__ __forceinline__ void e_branch_a(GAS char* PAg, const GAS char* CAg, const float* conv_a, unsigned off0, int t0, int c0) {
    {
        unsigned craw[34], braw[32];
        { unsigned off = off0;
#pragma unroll
          for (int j = 0; j < 34; ++j) { craw[j] = *(const GAS unsigned*)(CAg + off); off += D * 2; OPAQUE(off); } }
        { unsigned off = off0;
#pragma unroll
          for (int i = 0; i < 32; ++i) { braw[i] = *(const GAS unsigned*)(PAg + off); off += D * 2; OPAQUE(off); } }
        const f32x2 w0 = *(const GAS f32x2*)(conv_a + c0), w1 = *(const GAS f32x2*)(conv_a + D + c0), w2 = *(const GAS f32x2*)(conv_a + 2 * D + c0);
        if (t0 == 0) { craw[0] = 0u; craw[1] = 0u; }
        unsigned off = off0;
#pragma unroll
        for (int i = 0; i < 32; ++i) {
            const f32x2 z = w0 * unpk(craw[i]) + w1 * unpk(craw[i + 1]) + w2 * unpk(craw[i + 2]);
            const f32x2 o = z * unpk(braw[i]);
            *(GAS unsigned*)(PAg + off) = cvt_pk_bf16(o.x, o.y); off += D * 2; OPAQUE(off);
        }
    }
}
__device__ __forceinline__ void e_branch_c(const GAS char* CINg, GAS char* PCg, unsigned off0, int t0, int wave) {
    {
        unsigned praw[47];
        { unsigned off = off0;
#pragma unroll
          for (int j = 0; j < 47; ++j) { praw[j] = *(const GAS unsigned*)(CINg + off); off += D * 2; OPAQUE(off); } }
        if (t0 == 0) {
#pragma unroll
            for (int j = 0; j < 15; ++j) praw[j] = 0u;
        }
        if (wave < 2) pool_compute<2>(praw, PCg, off0, t0);
        else if (wave < 4) pool_compute<4>(praw, PCg, off0, t0);
        else if (wave < 6) pool_compute<8>(praw, PCg, off0, t0);
        else pool_compute<16>(praw, PCg, off0, t0);
    }
}
__device__ __forceinline__ void e_branch_b_conv(const GAS char* Ug, const f32x2 (&wk)[31], f32x2 cb, LAS f32x2* conv, unsigned off0, int t0, int tid, int ch_lo, int ch_hi) {
#pragma unroll 1
    for (int ch = ch_lo; ch < ch_hi; ++ch) {
        unsigned uraw[38];
        unsigned off = off0 + (unsigned)(ch * 8 * D * 2);
#pragma unroll
        for (int j = 0; j < 38; ++j) { uraw[j] = *(const GAS unsigned*)(Ug + off); off += D * 2; OPAQUE(off); }
        f32x2 uf[38];
#pragma unroll
        for (int j = 0; j < 38; ++j) uf[j] = ((t0 > 0) || (ch * 8 + j - 30 >= 0)) ? unpk(uraw[j]) : (f32x2){0.f, 0.f};
#pragma unroll
        for (int i = 0; i < 8; ++i) { f32x2 acc = cb;
#pragma unroll
            for (int k = 0; k < 31; ++k) acc += wk[k] * uf[i + k];
            conv[(ch * 8 + i) * 512 + tid] = acc; }
    }
}
__device__ __forceinline__ int opaque_idx_e(int k) { asm volatile("" : "+s"(k)); return k; }
__device__ __forceinline__ void e_phase(LAS unsigned char* lds, const Args& a, unsigned char* ws, int l, int G) {
    GAS char* PAg = (GAS char*)(ws + WS_PA); const GAS char* CAg = (const GAS char*)(ws + WS_CA) - 2 * D * 2; const GAS char* Ug = (const GAS char*)(ws + WS_U) - 30 * D * 2;
    const GAS char* CINg = (const GAS char*)(ws + WS_CIN) - 15 * D * 2; GAS char* PCg = (GAS char*)(ws + WS_PC); bf16_t* PB = (bf16_t*)(ws + WS_PB);
    const float* conv_a = a.in[opaque_idx_e(4)] + (size_t)l * 3 * D; const float* conv_b = a.in[opaque_idx_e(6)] + (size_t)l * 31 * D; const float* cbias = a.in[opaque_idx_e(7)] + (size_t)l * D;
    const float* ln_g = a.in[opaque_idx_e(8)] + (size_t)l * D; const float* ln_b = a.in[opaque_idx_e(9)] + (size_t)l * D;
    int tid_ = threadIdx.x; OPAQUE(tid_);
    const int tid = tid_, lane = tid & 63, wave = __builtin_amdgcn_readfirstlane(tid >> 6), c0 = 2 * tid;
    LAS f32x2* conv = (LAS f32x2*)lds;
    f32x2 wk[31];
#pragma unroll
    for (int k = 0; k < 31; ++k) wk[k] = *(const GAS f32x2*)(conv_b + (size_t)k * D + c0);
    const f32x2 cb = *(const GAS f32x2*)(cbias + c0);
    for (int it = blockIdx.x; it < M / 32; it += G) {
        const int m0 = it * 32, t0 = m0 & (SEQ - 1);
        const unsigned off0 = (unsigned)(m0 * D + c0) * 2u;
        if (wave < 4) { e_branch_a(PAg, CAg, conv_a, off0, t0, c0); e_branch_b_conv(Ug, wk, cb, conv, off0, t0, tid, 0, 2); e_branch_c(CINg, PCg, off0, t0, wave); e_branch_b_conv(Ug, wk, cb, conv, off0, t0, tid, 2, 4); }
        else          { e_branch_b_conv(Ug, wk, cb, conv, off0, t0, tid, 0, 2); e_branch_a(PAg, CAg, conv_a, off0, t0, c0); e_branch_b_conv(Ug, wk, cb, conv, off0, t0, tid, 2, 4); e_branch_c(CINg, PCg, off0, t0, wave); }
        __syncthreads();
        {
            f32x4 lg[4], lb[4];
#pragma unroll
            for (int j = 0; j < 4; ++j) { lg[j] = *(const GAS f32x4*)(ln_g + 4 * lane + 256 * j); lb[j] = *(const GAS f32x4*)(ln_b + 4 * lane + 256 * j); }
#pragma unroll 1
            for (int r = 0; r < 4; ++r) { const int row = wave * 4 + r;
                f32x4 v[4]; float s1 = 0.f, s2 = 0.f;
#pragma unroll
                for (int j = 0; j < 4; ++j) { v[j] = *(const LAS f32x4*)((const LAS float*)conv + row * 1024 + 4 * lane + 256 * j);
                    s1 += (v[j][0] + v[j][1]) + (v[j][2] + v[j][3]); s2 += (v[j][0] * v[j][0] + v[j][1] * v[j][1]) + (v[j][2] * v[j][2] + v[j][3] * v[j][3]); }
                s1 = wave_sum(s1, lane); s2 = wave_sum(s2, lane);
                const float mean = s1 * (1.0f / D); float var = s2 * (1.0f / D) - mean * mean; var = var > 0.f ? var : 0.f;
                const float rstd = rsqrtf(var + EPS);
                GAS unsigned long long* o8 = (GAS unsigned long long*)(PB + (size_t)(m0 + row) * D) + lane;
#pragma unroll
                for (int j = 0; j < 4; ++j) { const f32x4 y = (v[j] - mean) * rstd * lg[j] + lb[j];
                    o8[64 * j] = (unsigned long long)cvt_pk_bf16(y[0] * sigm(y[0]), y[1] * sigm(y[1])) | ((unsigned long long)cvt_pk_bf16(y[2] * sigm(y[2]), y[3] * sigm(y[3])) << 32); }
            }
        }
        __syncthreads();
    }
}

#define XB_TMO      128
#define XB_XCNT(j)  (256  + 64 * (j))
#define XB_XSUB(j)  (1280 + 64 * (j))
#define XB_XGEN(j)  (2304 + 64 * (j))
#define XB_TOP      3328
#define XB_TOPGEN   3392
#define XCD_BAR_WORDS 3456
#define XB_SPIN_CAP (1u << 18)
__device__ __forceinline__ unsigned xb_ld(unsigned* p)              { return __hip_atomic_load(p, __ATOMIC_RELAXED, __HIP_MEMORY_SCOPE_AGENT); }
__device__ __forceinline__ unsigned xb_add(unsigned* p, unsigned v) { return __hip_atomic_fetch_add(p, v, __ATOMIC_RELAXED, __HIP_MEMORY_SCOPE_AGENT); }
__device__ __forceinline__ unsigned xb_xcc_id() { return (unsigned)__builtin_amdgcn_s_getreg((3 << 11) | 20) & 0xFu; }
#define XB_SPIN(cond, bar) do { unsigned _sp = 0; while (cond) { __builtin_amdgcn_s_sleep(1); \
    if ((++_sp & 255u) == 0u) { if (xb_ld(&(bar)[XB_TMO])) break; if (_sp > XB_SPIN_CAP) { atomicAdd(&(bar)[XB_TMO], 1u); break; } } } } while (0)
__device__ __forceinline__ void xcd_barrier_complete(unsigned* bar, unsigned x, unsigned& nloc, unsigned& nx) {
    const unsigned G = gridDim.x * gridDim.y * gridDim.z;
    unsigned sum, cnt, mine, sp = 0u;
    for (;;) {
        sum = 0u; cnt = 0u; mine = 0u;
#pragma unroll
        for (unsigned j = 0; j < 16; ++j) { const unsigned c = xb_ld(&bar[XB_XCNT(j)]); sum += c; cnt += (c > 0u) ? 1u : 0u; mine = (j == x) ? c : mine; }
        if (sum == G) break;
        __builtin_amdgcn_s_sleep(1);
        if ((++sp & 255u) == 0u) { if (xb_ld(&bar[XB_TMO])) break; if (sp > XB_SPIN_CAP) { atomicAdd(&bar[XB_TMO], 1u); break; } }
    }
    nloc = mine > 0u ? mine : 1u; nx = cnt > 0u ? cnt : 1u;
}
__device__ __forceinline__ void xcd_barrier(unsigned* bar, volatile LAS unsigned* st) {
    asm volatile("s_waitcnt vmcnt(0)" ::: "memory");
    __syncthreads();
    if (threadIdx.x == 0) {
        __builtin_amdgcn_s_waitcnt(0);
        const unsigned x = xb_xcc_id();
        unsigned nloc = st[0], nx = st[1];
        if (nloc == 0u) { xcd_barrier_complete(bar, x, nloc, nx); st[0] = nloc; st[1] = nx; }
        const unsigned old = xb_add(&bar[XB_XSUB(x)], 1u);
        const unsigned gen = old / nloc;
        if (old + 1u == (gen + 1u) * nloc) {
            __builtin_amdgcn_fence(__ATOMIC_RELEASE, "agent");
            asm volatile("s_waitcnt vmcnt(0)" ::: "memory");
            const unsigned og = xb_add(&bar[XB_TOP], 1u);
            const unsigned tg = og / nx;
            if (og + 1u == (tg + 1u) * nx) xb_add(&bar[XB_TOPGEN], 1u);
            else XB_SPIN(xb_ld(&bar[XB_TOPGEN]) == tg, bar);
            __builtin_amdgcn_fence(__ATOMIC_ACQUIRE, "agent");
            xb_add(&bar[XB_XGEN(x)], 1u);
            asm volatile("s_waitcnt vmcnt(0)" ::: "memory");
        } else {
            XB_SPIN(xb_ld(&bar[XB_XGEN(x)]) == gen, bar);
            __builtin_amdgcn_fence(__ATOMIC_ACQUIRE, "agent");
            asm volatile("s_waitcnt vmcnt(0)" ::: "memory");
        }
    }
    __syncthreads();
}

#define LAUNDER_S(p) asm volatile("" : "+s"(p))
__device__ __forceinline__ int opaque_idx(int k) { asm volatile("" : "+s"(k)); return k; }
#define AIN(k) (a.in[opaque_idx(k)])
__global__ void __launch_bounds__(512, 2) mk_fwd(Args a) {
    __shared__ __attribute__((aligned(16))) unsigned char lds_raw[LDS_BYTES];
    LAS unsigned char* lds = (LAS unsigned char*)lds_raw;
    volatile LAS unsigned* bst = (volatile LAS unsigned*)(lds + MISC_OFF);
    if (threadIdx.x < 2) bst[threadIdx.x] = 0u;
    __syncthreads();
    if (a.ph_hi - a.ph_lo > 1 && threadIdx.x == 0) (void)xb_add((unsigned*)a.ws + XB_XCNT(xb_xcc_id()), 1u);
#ifndef PROBE_REPS
#define PROBE_REPS 0
#define PROBE_PHASE 0
#endif
    const int hi = a.ph_hi + PROBE_REPS;
#pragma unroll 1
    for (int q = a.ph_lo; q < hi; ++q) {
        const bool probe = PROBE_REPS > 0 && q >= NPH;
        const int p = probe ? PROBE_PHASE : q;
        const int l = p / 7, k = p - 7 * l;
        int G = gridDim.x, bx = blockIdx.x; LAUNDER_S(G); LAUNDER_S(bx);
        unsigned char* ws = a.ws; LAUNDER_S(ws);
        float* SSQ = (float*)(ws + WS_SSQ);
        if (p == 7 * DEPTH) {
            if (PH_MASK & 128) {
                int tid_ = threadIdx.x; OPAQUE(tid_);
                const int lane = tid_ & 63, gw = bx * 8 + (tid_ >> 6), NGW = G * 8;
                const float* gf = AIN(18); const bf16_t* XB = (const bf16_t*)(ws + WS_XB);
                f32x4 g4[2][2];
#pragma unroll
                for (int j = 0; j < 2; ++j) { g4[j][0] = *(const GAS f32x4*)(gf + 8 * lane + 512 * j); g4[j][1] = *(const GAS f32x4*)(gf + 8 * lane + 512 * j + 4); }
                for (int m = gw; m < M; m += NGW) {
                    const u32x4 w0 = *(const GAS u32x4*)(XB + (size_t)m * D + 8 * lane), w1 = *(const GAS u32x4*)(XB + (size_t)m * D + 8 * lane + 512);
                    const float rs = row_rs(SSQ, m);
                    float* o = a.out + (size_t)m * D + 8 * lane;
                    *(GAS f32x4*)(o) = pg8::bfx4_lo(w0) * rs * g4[0][0]; *(GAS f32x4*)(o + 4) = pg8::bfx4_hi(w0) * rs * g4[0][1];
                    *(GAS f32x4*)(o + 512) = pg8::bfx4_lo(w1) * rs * g4[1][0]; *(GAS f32x4*)(o + 516) = pg8::bfx4_hi(w1) * rs * g4[1][1];
                }
            }
        } else if (k == 0) {
            if (PH_MASK & 1) {
                int tid_ = threadIdx.x; OPAQUE(tid_);
                const int lane = tid_ & 63, wave = __builtin_amdgcn_readfirstlane(tid_ >> 6), gw = bx * 8 + wave, NGW = G * 8;
                bf16_t* WIN = (bf16_t*)(ws + WS_WIN); bf16_t* WA = (bf16_t*)(ws + WS_WA); bf16_t* WB = (bf16_t*)(ws + WS_WB); bf16_t* WP = (bf16_t*)(ws + WS_WP);
                bf16_t* WO = (bf16_t*)(ws + WS_WO); bf16_t* W1 = (bf16_t*)(ws + WS_W1); bf16_t* W2 = (bf16_t*)(ws + ((l & 1) ? WS_W2B : WS_W2)); bf16_t* XB = (bf16_t*)(ws + WS_XB);
                LAS float* scr = (LAS float*)(lds + wave * 16384);
                const float* g_mix = AIN(1) + (size_t)l * D; const float* w_in = AIN(2) + (size_t)l * D * PIN;
                const float* w_a = AIN(5) + (size_t)l * D * D; const float* w_b = AIN(10) + (size_t)l * D * D; const float* w_p = AIN(12) + (size_t)l * 4 * 65536;
                const float* w_o = AIN(14) + (size_t)l * D * D; const float* g_mlp = AIN(15) + (size_t)l * D; const float* w_1 = AIN(16) + (size_t)l * D * FF; const float* w_2 = AIN(17) + (size_t)l * FF * D;
                constexpr int I_IN = 16 * 288, I_SQ = 16 * 32, I_P = 128, I_1 = 16 * 128, I_2 = 64 * 32, NITEMS = I_IN + 3 * I_SQ + I_P + I_1 + I_2;
                for (int it = gw; it < NITEMS; it += NGW) {
                    int r = it;
                    if (r < I_IN) { const int kb = r / 288, nb = r - kb * 288; tr_item(w_in, PIN, g_mix, WIN, D, kb * 64, nb * 32, win_row(nb * 32), scr, lane); continue; } r -= I_IN;
                    if (r < I_SQ) { tr_item(w_a, D, nullptr, WA, D, (r >> 5) * 64, (r & 31) * 32, (r & 31) * 32, scr, lane); continue; } r -= I_SQ;
                    if (r < I_SQ) { tr_item(w_b, D, nullptr, WB, D, (r >> 5) * 64, (r & 31) * 32, (r & 31) * 32, scr, lane); continue; } r -= I_SQ;
                    if (r < I_SQ) { tr_item(w_o, D, nullptr, WO, D, (r >> 5) * 64, (r & 31) * 32, (r & 31) * 32, scr, lane); continue; } r -= I_SQ;
                    if (r < I_P) { const int gi = r >> 5, kb = (r & 31) >> 3, nb = r & 7; tr_item(w_p + (size_t)gi * 65536, 256, nullptr, WP, D, kb * 64, nb * 32, gi * 256 + nb * 32, scr, lane, AIN(13) + (size_t)l * D + gi * 256 + nb * 32); continue; } r -= I_P;
                    if (r < I_1) { const int kb = r >> 7, nb = r & 127; tr_item(w_1, FF, g_mlp, W1, D, kb * 64, nb * 32, nb * 32, scr, lane); continue; } r -= I_1;
                    { const int kb = r >> 5, nb = r & 31; tr_item(w_2, D, nullptr, W2, FF, kb * 64, nb * 32, nb * 32, scr, lane); }
                }
                if (l == 0) {
                    const float* x = AIN(0);
                    for (int m = gw; m < M; m += NGW) {
                        const f32x4* xr = (const f32x4*)(x + (size_t)m * D) + lane; f32x4 v[4]; float s = 0.f;
#pragma unroll
                        for (int j = 0; j < 4; ++j) { v[j] = xr[64 * j]; s += (v[j][0] * v[j][0] + v[j][1] * v[j][1]) + (v[j][2] * v[j][2] + v[j][3] * v[j][3]); }
                        s = wave_sum(s, lane);
                        unsigned long long* o8 = (unsigned long long*)(XB + (size_t)m * D) + lane;
#pragma unroll
                        for (int j = 0; j < 4; ++j) o8[64 * j] = (unsigned long long)cvt_pk_bf16(v[j][0], v[j][1]) | ((unsigned long long)cvt_pk_bf16(v[j][2], v[j][3]) << 32);
                        if (lane < 16) SSQ[(size_t)m * 16 + lane] = lane == 0 ? s : 0.f;
                    }
                }
                __syncthreads();
            }
        } else if (k == 1) {
            if (PH_MASK & 2) {
                pg8::SchedPlain S; S.T.init(M, 6144, G, bx); S.A = (const char*)(ws + WS_XB); S.B = (const char*)(ws + WS_WIN); S.atile = (size_t)256 * D * 2; S.btile = (size_t)256 * D * 2; S.nt = D / 64;
                LAS float* rsl = (LAS float*)(lds + RING_BYTES);
                { pg8::Unit t; for (int j = 0; j < pg8::RS_MAX_ORD && S.next(j, t); ++j) pg8::rs_table_fill(rsl, j, t.pm, SSQ); }
                __syncthreads();
                pg8::EpiG1 E{ws, AIN(3) + (size_t)l * PIN, SSQ, rsl};
                pg8::gemm_phase(lds, pg8::Gemm{D, D}, S, E);
            }
        } else if (k == 2) {
            if (PH_MASK & 4) e_phase(lds, a, ws, l, G);
        } else if (k == 3) {
            if (PH_MASK & 8) {
                pg8::SchedG2 S; S.T.init(M, D, G, bx); S.ws = (const char*)ws;
                LAS float* rsl = (LAS float*)(lds + RING_BYTES);
                { int pm, pn; for (int j = 0; j < pg8::RS_MAX_ORD && S.T.tile(j, pm, pn); ++j) pg8::rs_table_fill(rsl, j, pm, SSQ); }
                __syncthreads();
                pg8::EpiG2 E{ws, AIN(3) + (size_t)l * PIN + 6144, AIN(11) + (size_t)l * D, AIN(13) + (size_t)l * D, SSQ, rsl};
                pg8::gemm_phase(lds, pg8::Gemm{D, D}, S, E);
            }
        } else if (k == 4) {
            if (PH_MASK & 16) {
                pg8::SchedPlain S; S.T.init(M, D, G, bx); S.A = (const char*)(ws + WS_MRG); S.B = (const char*)(ws + WS_WO); S.atile = (size_t)256 * D * 2; S.btile = (size_t)256 * D * 2; S.nt = D / 64;
                pg8::EpiX E{(bf16_t*)(ws + (probe ? WS_PB : WS_XB)), SSQ};
                pg8::gemm_phase(lds, pg8::Gemm{D, D}, S, E);
            }
        } else if (k == 5) {
            if (PH_MASK & 32) {
                pg8::SchedPlain S; S.T.init(M, FF, G, bx); S.A = (const char*)(ws + WS_XB); S.B = (const char*)(ws + WS_W1); S.atile = (size_t)256 * D * 2; S.btile = (size_t)256 * D * 2; S.nt = D / 64;
                LAS float* rsl = (LAS float*)(lds + RING_BYTES);
                { pg8::Unit t; for (int j = 0; j < pg8::RS_MAX_ORD && S.next(j, t); ++j) pg8::rs_table_fill(rsl, j, t.pm, SSQ); }
                __syncthreads();
                pg8::EpiG4 E{(bf16_t*)(ws + WS_HID), SSQ, rsl};
                pg8::gemm_phase(lds, pg8::Gemm{D, D}, S, E);
            }
        } else {
            if (PH_MASK & 64) {
                pg8::SchedPlain S; S.T.init(M, D, G, bx); S.A = (const char*)(ws + WS_HID); S.B = (const char*)(ws + ((l & 1) ? WS_W2B : WS_W2)); S.atile = (size_t)256 * FF * 2; S.btile = (size_t)256 * FF * 2; S.nt = FF / 64;
                pg8::EpiX E{(bf16_t*)(ws + (probe ? WS_PB : WS_XB)), SSQ};
                pg8::gemm_phase(lds, pg8::Gemm{FF, FF}, S, E);
            }
        }
        const bool seam_free = !probe && k == 6 && q + 1 < NPH && (q + 1) < 7 * DEPTH;
        if (q + 1 < hi && !seam_free) { if (a.ph_lo < 0) cg::this_grid().sync(); else xcd_barrier((unsigned*)a.ws, bst); }
    }
}


#ifdef DUMP_AFTER
__global__ void dump_k(const unsigned char* ws, float* out, int which) {
    const size_t n = (size_t)M * D; const bf16_t* b0 = (const bf16_t*)(ws + WS_PA); const bf16_t* b1 = (const bf16_t*)(ws + WS_PB); const bf16_t* b2 = (const bf16_t*)(ws + WS_PC);
    const bf16_t* sc = (const bf16_t*)(ws + WS_MRG); const bf16_t* xb = (const bf16_t*)(ws + WS_XB);
    for (size_t i = blockIdx.x * (size_t)blockDim.x + threadIdx.x; i < n; i += (size_t)gridDim.x * blockDim.x) {
        float v;
        if (which == 1) v = __uint_as_float((unsigned)b0[i] << 16) + 2.f * __uint_as_float((unsigned)((const bf16_t*)(ws + WS_CA))[i] << 16) + 4.f * __uint_as_float((unsigned)((const bf16_t*)(ws + WS_U))[i] << 16) + 8.f * __uint_as_float((unsigned)((const bf16_t*)(ws + WS_CIN))[i] << 16);
        else if (which == 2) v = __uint_as_float((unsigned)b0[i] << 16) + 2.f * __uint_as_float((unsigned)b1[i] << 16) + 4.f * __uint_as_float((unsigned)b2[i] << 16);
        else if (which == 3) v = __uint_as_float((unsigned)sc[i] << 16);
        else v = __uint_as_float((unsigned)xb[i] << 16);
        out[i] = v;
    }
}
#endif
extern "C" void kernel_launch(void* const* d_in, const int* in_sizes, int n_in, void* d_out, int out_size, void* d_ws, size_t ws_size, hipStream_t stream) {
    static int grid = 0;
    if (grid == 0) {
        if (n_in != 19 || in_sizes[0] != M * D || out_size != M * D || ws_size < WS_END) { fprintf(stderr, "kernel_launch: unexpected shapes (n_in %d, in0 %d, out %d, ws %zu)\n", n_in, n_in > 0 ? in_sizes[0] : -1, out_size, ws_size); grid = -1; return; }
        int dev = 0, cus = 0, per_cu = 0;
        if (hipGetDevice(&dev) != hipSuccess || hipDeviceGetAttribute(&cus, hipDeviceAttributeMultiprocessorCount, dev) != hipSuccess) { grid = -1; return; }
        if (hipOccupancyMaxActiveBlocksPerMultiprocessor(&per_cu, (const void*)mk_fwd, 512, 0) != hipSuccess || per_cu < 1) { fprintf(stderr, "kernel_launch: occupancy query says %d\n", per_cu); per_cu = 1; }
        (void)hipGetLastError();
        grid = cus * 1;
    }
    if (grid < 0) return;
    Args a{};
    for (int i = 0; i < 19; ++i) a.in[i] = (const float*)d_in[i];
    a.out = (float*)d_out; a.ws = (unsigned char*)d_ws;
#if MK_N_LAUNCHES == 1
    if (hipMemsetAsync(d_ws, 0, 16384, stream) != hipSuccess) { fprintf(stderr, "kernel_launch: memset of the barrier words failed\n"); return; }
    a.ph_lo = 0; a.ph_hi = NPH;
    void* args[] = {&a};
    hipError_t e = hipLaunchCooperativeKernel((const void*)mk_fwd, dim3(grid), dim3(512), args, 0, stream);
    if (e != hipSuccess) fprintf(stderr, "kernel_launch: cooperative launch failed: %s (grid %d)\n", hipGetErrorString(e), grid);
#else
#ifdef DUMP_AFTER
    for (int p = 0; p <= DUMP_AFTER; ++p) { a.ph_lo = p; a.ph_hi = p + 1; hipLaunchKernelGGL(mk_fwd, dim3(grid), dim3(512), 0, stream, a); }
    hipLaunchKernelGGL(dump_k, dim3(2048), dim3(256), 0, stream, (const unsigned char*)d_ws, (float*)d_out, (int)DUMP_AFTER);
#else
    for (int p = 0; p < NPH; ++p) { a.ph_lo = p; a.ph_hi = p + 1; hipLaunchKernelGGL(mk_fwd, dim3(grid), dim3(512), 0, stream, a); }
#endif
#endif
}
```

```cpp
#include <hip/hip_runtime.h>
#include <hip/hip_cooperative_groups.h>
#include <cstdio>
#include <cstdint>
namespace cg = cooperative_groups;

#ifndef PH_MASK
#define PH_MASK 0xff
#endif
#ifndef MK_N_LAUNCHES
#define MK_N_LAUNCHES 1
#endif

#define LAS __attribute__((address_space(3)))
typedef unsigned short bf16_t;
typedef short bf16x8 __attribute__((ext_vector_type(8)));
typedef float f32x4 __attribute__((ext_vector_type(4)));
typedef float f32x2 __attribute__((ext_vector_type(2)));
typedef unsigned u32x4 __attribute__((ext_vector_type(4)));

constexpr int M = 16384, D = 1024, SEQ = 8192, PIN = 9216, FF = 4096, DEPTH = 2;
constexpr float EPS = 1e-6f;
constexpr int NPH = 7 * DEPTH + 1;

constexpr size_t MiB = 1u << 20;
constexpr size_t WS_WIN = 1 * MiB, WS_WA = 19 * MiB, WS_WB = 21 * MiB, WS_WP = 23 * MiB, WS_WO = 25 * MiB, WS_W1 = 27 * MiB, WS_W2 = 35 * MiB, WS_SSQ = 43 * MiB;
constexpr size_t WS_XB = 44 * MiB, WS_PA = 76 * MiB, WS_CA = 108 * MiB, WS_U = 140 * MiB, WS_CIN = 172 * MiB, WS_PB = 204 * MiB, WS_PC = 236 * MiB, WS_W2B = 268 * MiB, WS_END = 276 * MiB;
constexpr size_t WS_HID = WS_PA;
constexpr size_t WS_GQ0 = WS_CA, WS_GQ1 = WS_CA + 16 * MiB, WS_GQ2 = WS_U;
constexpr size_t WS_MRG = WS_CIN;
static_assert(WS_HID + (size_t)M * FF * 2 <= WS_PB && WS_GQ2 + (size_t)M * D <= WS_CIN && WS_MRG + (size_t)M * D * 2 <= WS_PB, "ws map");

constexpr int RING_BYTES = 131072, RS_BYTES = 16384, MISC_OFF = RING_BYTES + RS_BYTES, LDS_BYTES = MISC_OFF + 256;

#define OPAQUE(v) asm volatile("" : "+v"(v))
typedef __bf16 bf16x2_t __attribute__((ext_vector_type(2)));
__device__ __forceinline__ unsigned cvt_pk_bf16(float lo, float hi) { const f32x2 v = {lo, hi}; const bf16x2_t b = __builtin_convertvector(v, bf16x2_t); return __builtin_bit_cast(unsigned, b); }
__device__ __forceinline__ float bf_lo(unsigned w) { return __uint_as_float(w << 16); }
__device__ __forceinline__ float bf_hi(unsigned w) { return __uint_as_float(w & 0xffff0000u); }
__device__ __forceinline__ float sigm(float x) { return __builtin_amdgcn_rcpf(1.0f + __builtin_amdgcn_exp2f(-1.4426950408889634f * x)); }
__device__ __forceinline__ f32x4 sigm4(f32x4 v) { return (f32x4){sigm(v[0]), sigm(v[1]), sigm(v[2]), sigm(v[3])}; }
__device__ __forceinline__ u32x4 pack8(f32x4 a, f32x4 b) { u32x4 w; w.x = cvt_pk_bf16(a[0], a[1]); w.y = cvt_pk_bf16(a[2], a[3]); w.z = cvt_pk_bf16(b[0], b[1]); w.w = cvt_pk_bf16(b[2], b[3]); return w; }
__device__ __forceinline__ float row_rs(const float* ssq, int row) {
    const f32x4* p = (const f32x4*)(ssq + (size_t)row * 16); const f32x4 a = p[0], b = p[1], c = p[2], d = p[3];
    const float s = ((a[0] + a[1]) + (a[2] + a[3])) + ((b[0] + b[1]) + (b[2] + b[3])) + ((c[0] + c[1]) + (c[2] + c[3])) + ((d[0] + d[1]) + (d[2] + d[3]));
    return rsqrtf(s * (1.0f / D) + EPS);
}
__device__ __forceinline__ float shx(float v, int mask, int lane) { return __builtin_bit_cast(float, __builtin_amdgcn_ds_bpermute((lane ^ mask) << 2, __builtin_bit_cast(int, v))); }
__device__ __forceinline__ float wave_sum(float v, int lane) {
#pragma unroll
    for (int o = 1; o < 64; o <<= 1) v += shx(v, o, lane);
    return v;
}

namespace pg8 {
constexpr int BM = 256, BK = 64, HALF = 128, HTB = HALF * BK * 2, NXCD = 8, WGM = 4;
__host__ __device__ __forceinline__ int lds_byte(int r, int c) { const int st = (r >> 4) * 2 + (c >> 5), rr = r & 15, cc = c & 31, ob = rr * 64 + cc * 2; return st * 1024 + (ob ^ (((ob >> 9) & 1) << 5)); }
__host__ __device__ __forceinline__ void stage_rc(int b, int& R, int& C) { const int st = b / 1024, sb = b % 1024, swz = sb ^ (((sb >> 9) & 1) << 5); R = (st >> 1) * 16 + swz / 64; C = (st & 1) * 32 + (swz % 64) / 2; }
__host__ __device__ __forceinline__ int perm32(int rho) { const int n = rho >> 4, i = rho & 15; return 8 * (i >> 2) + 4 * n + (i & 3); }

struct Unit { int pm, pn, kind, nt, ord, n0, n1; const char* A; const char* B; const char* A1; const char* B1; const char* A2; const char* B2; };
struct Gemm { int lda, ldb; };

struct TileSched {
    int nM, nN, nwg, G, c;
    __device__ void init(int M_, int N_, int G_, int c_) { nM = M_ / BM; nN = N_ / BM; nwg = nM * nN; G = G_; c = c_; }
    __device__ bool tile(int i, int& pm, int& pn) const {
        const long L = (long)i * G + c; if (L >= nwg) return false;
        int wgid = (int)L; { const int q = nwg / NXCD, r = nwg % NXCD, xcd = wgid % NXCD, off = wgid / NXCD; wgid = (xcd < r ? xcd * (q + 1) : r * (q + 1) + (xcd - r) * q) + off; }
        const int nig = WGM * nN, gid = wgid / nig, fm = gid * WGM, gsz = (nM - fm) < WGM ? (nM - fm) : WGM;
        pm = fm + ((wgid % nig) % gsz); pn = (wgid % nig) / gsz; return true;
    }
};
struct SchedPlain {
    TileSched T; const char* A; const char* B; size_t atile, btile; int nt;
    __device__ bool next(int i, Unit& u) const { int pm, pn; if (!T.tile(i, pm, pn)) return false; u.pm = pm; u.pn = pn; u.kind = 0; u.nt = nt; u.ord = i; u.n0 = nt; u.n1 = nt; u.A = A + (size_t)pm * atile; u.B = B + (size_t)pn * btile; return true; }
};
struct SchedG2 {
    TileSched T; const char* ws;
    __device__ bool next(int i, Unit& u) const {
        const int ti = i >> 2, kind = i & 3; int pm, pn; if (!T.tile(ti, pm, pn)) return false;
        const size_t ar = (size_t)pm * (256 * 1024 * 2), br = (size_t)pn * (256 * 1024 * 2);
        u.pm = pm; u.pn = pn; u.kind = kind; u.ord = ti;
        if (kind < 3) { u.nt = 16; u.n0 = 16; u.n1 = 16; u.A = ws + WS_XB + ar; u.B = ws + WS_WIN + (size_t)6144 * 2048 + (size_t)kind * (1024 * 1024 * 2) + br; u.A1 = u.A; u.B1 = u.B; u.A2 = u.A; u.B2 = u.B; }
        else { u.nt = 36; u.n0 = 16; u.n1 = 32; u.A = ws + WS_PA + ar; u.B = ws + WS_WA + br; u.A1 = ws + WS_PB + ar; u.B1 = ws + WS_WB + br; u.A2 = ws + WS_PC + ar + (size_t)pn * 512; u.B2 = ws + WS_WP + br; }
        return true;
    }
};

template <class Epi, class Sched>
__device__ __forceinline__ void gemm_phase(LAS unsigned char* lds, const Gemm g, const Sched& S, const Epi& E) {
    int tid_ = threadIdx.x; OPAQUE(tid_);
    const int tid = tid_, wid = __builtin_amdgcn_readfirstlane(tid >> 6), lane = tid & 63, wr = wid >> 2, wc = wid & 3, fr = lane & 15, fq = lane >> 4;
    unsigned voffA[2], voffB[2];
#pragma unroll
    for (int i = 0; i < 2; ++i) { int R, C; stage_rc(tid * 16 + i * 8192, R, C); const int Rb = (R & ~31) + perm32(R & 31);
        voffA[i] = (unsigned)(R * g.lda + C) * 2u; voffB[i] = (unsigned)(Rb * g.ldb + C) * 2u; }
    const size_t kstep = (size_t)(BK * 2);
    const size_t hstepA = (size_t)HALF * g.lda * 2, hstepB = (size_t)HALF * g.ldb * 2;
    const unsigned ldsw = (unsigned)wid * 1024u;
    const int aoff = lds_byte(wr * 64 + fr, fq * 8), boff = lds_byte(wc * 32 + fr, fq * 8);
#define PG8_SA(b, h) (((b) * 2 + (h)) * HTB)
#define PG8_SB(b, h) ((4 + (b) * 2 + (h)) * HTB)
#define PG8_STAGE(bufoff, gbase, voff) do { _Pragma("unroll") for (int _i = 0; _i < 2; ++_i) \
        __builtin_amdgcn_global_load_lds((const unsigned*)((const char*)(gbase) + (voff)[_i]), (LAS unsigned*)(lds + (bufoff) + ldsw + _i * 8192), 16, 0, 0); } while (0)
#define PG8_LDA(dst, b, h) do { _Pragma("unroll") for (int m = 0; m < 4; ++m) _Pragma("unroll") for (int k = 0; k < 2; ++k) dst[m][k] = *(const LAS bf16x8*)(lds + PG8_SA(b, h) + aoff + m * 2048 + k * 1024); } while (0)
#define PG8_LDB(dst, b, h) do { _Pragma("unroll") for (int n = 0; n < 2; ++n) _Pragma("unroll") for (int k = 0; k < 2; ++k) dst[n][k] = *(const LAS bf16x8*)(lds + PG8_SB(b, h) + boff + n * 2048 + k * 1024); } while (0)
#define PG8_MMA(ai, bj, At, Bt) do { __builtin_amdgcn_s_setprio(1); _Pragma("unroll") for (int m = 0; m < 4; ++m) _Pragma("unroll") for (int n = 0; n < 2; ++n) _Pragma("unroll") for (int k = 0; k < 2; ++k) \
        acc[ai][bj][m][n] = __builtin_amdgcn_mfma_f32_16x16x32_bf16(Bt[n][k], At[m][k], acc[ai][bj][m][n], 0, 0, 0); __builtin_amdgcn_s_setprio(0); } while (0)
#define PG8_WAIT_V(n) asm volatile("s_waitcnt vmcnt(" #n ")" ::: "memory")
#define PG8_WAIT_L(n) asm volatile("s_waitcnt lgkmcnt(" #n ")" ::: "memory")
#define PG8_BAR __builtin_amdgcn_s_barrier()
#define PG8_SCHED __builtin_amdgcn_sched_barrier(0)
    Unit cur, nxt; int ui = 0;
    if (!S.next(0, cur)) return;
    f32x4 acc[2][2][4][2];
#pragma unroll
    for (int a = 0; a < 2; ++a)
#pragma unroll
        for (int b = 0; b < 2; ++b)
#pragma unroll
            for (int m = 0; m < 4; ++m)
#pragma unroll
                for (int n = 0; n < 2; ++n) acc[a][b][m][n] = (f32x4){0.f, 0.f, 0.f, 0.f};
    bf16x8 At[4][2], B0[2][2], B1[2][2];
    const char* cA = cur.A; const char* cB = cur.B;
    PG8_STAGE(PG8_SB(0, 0), cB, voffB); PG8_STAGE(PG8_SB(0, 1), cB + hstepB, voffB); PG8_STAGE(PG8_SA(0, 0), cA, voffA); PG8_STAGE(PG8_SA(0, 1), cA + hstepA, voffA);
    if (wr == 1) PG8_BAR;
    PG8_WAIT_V(2); PG8_BAR;
    PG8_STAGE(PG8_SB(1, 0), cB + kstep, voffB); PG8_STAGE(PG8_SA(1, 0), cA + kstep, voffA); PG8_STAGE(PG8_SB(1, 1), cB + hstepB + kstep, voffB);
    PG8_WAIT_V(6); PG8_BAR;
    for (;;) {
        const bool has_next = S.next(ui + 1, nxt);
        const char* nA = has_next ? nxt.A : cA; const char* nB = has_next ? nxt.B : cB;
        const int nt = cur.nt;
        for (int t = 0; t < nt; t += 2) {
            const bool last = (t == nt - 2);
            const char *a1, *a2, *b2;
            if constexpr (Epi::HAS_MID) {
                const int t2 = t + 2;
                a1 = (t < cur.n0 ? cur.A + (size_t)t * kstep : (t < cur.n1 ? cur.A1 + (size_t)(t - cur.n0) * kstep : cur.A2 + (size_t)(t - cur.n1) * kstep)) + kstep;
                a2 = last ? nA : (t2 < cur.n0 ? cur.A + (size_t)t2 * kstep : (t2 < cur.n1 ? cur.A1 + (size_t)(t2 - cur.n0) * kstep : cur.A2 + (size_t)(t2 - cur.n1) * kstep));
                b2 = last ? nB : (t2 < cur.n0 ? cur.B + (size_t)t2 * kstep : (t2 < cur.n1 ? cur.B1 + (size_t)(t2 - cur.n0) * kstep : cur.B2 + (size_t)(t2 - cur.n1) * kstep));
            } else {
                a1 = cA + (size_t)(t + 1) * kstep;
                a2 = last ? nA : cA + (size_t)(t + 2) * kstep; b2 = last ? nB : cB + (size_t)(t + 2) * kstep;
            }
            const char* a3 = a2 + kstep; const char* b3 = b2 + kstep;
            PG8_LDB(B0, 0, 0); PG8_LDB(B1, 0, 1); PG8_SCHED; PG8_LDA(At, 0, 0); PG8_STAGE(PG8_SA(1, 1), a1 + hstepA, voffA);
            PG8_WAIT_V(8); PG8_WAIT_L(0); PG8_BAR; PG8_MMA(0, 0, At, B0); PG8_MMA(0, 1, At, B1); PG8_BAR; PG8_SCHED;
            PG8_LDA(At, 0, 1); PG8_STAGE(PG8_SB(0, 0), b2, voffB); PG8_STAGE(PG8_SB(0, 1), b2 + hstepB, voffB); PG8_STAGE(PG8_SA(0, 0), a2, voffA);
            PG8_WAIT_V(8); PG8_WAIT_L(0); PG8_BAR; PG8_MMA(1, 0, At, B0); PG8_MMA(1, 1, At, B1); PG8_BAR; PG8_SCHED;
            PG8_LDB(B0, 1, 0); PG8_LDB(B1, 1, 1); PG8_SCHED; PG8_LDA(At, 1, 0); PG8_STAGE(PG8_SA(0, 1), a2 + hstepA, voffA);
            PG8_WAIT_V(8); PG8_WAIT_L(0); PG8_BAR; PG8_MMA(0, 0, At, B0); PG8_MMA(0, 1, At, B1); PG8_BAR; PG8_SCHED;
            PG8_LDA(At, 1, 1); PG8_STAGE(PG8_SB(1, 0), b3, voffB); PG8_STAGE(PG8_SB(1, 1), b3 + hstepB, voffB); PG8_STAGE(PG8_SA(1, 0), a3, voffA);
            PG8_WAIT_V(8); PG8_WAIT_L(0); PG8_BAR; PG8_MMA(1, 0, At, B0); PG8_MMA(1, 1, At, B1); PG8_BAR; PG8_SCHED;
            if constexpr (Epi::HAS_MID) {
                if (t + 2 < nt && (t + 2 == cur.n0 || t + 2 == cur.n1)) { E.mid(acc, cur, t + 2 == cur.n0 ? 0 : 1, wr, wc, fr, fq); PG8_SCHED; }
            }
        }
        if (wr == 0) PG8_BAR;
        E(acc, cur, wr, wc, fr, fq);
        if (!has_next) break;
#pragma unroll
        for (int a = 0; a < 2; ++a)
#pragma unroll
            for (int b = 0; b < 2; ++b)
#pragma unroll
                for (int m = 0; m < 4; ++m)
#pragma unroll
                    for (int n = 0; n < 2; ++n) acc[a][b][m][n] = (f32x4){0.f, 0.f, 0.f, 0.f};
        cur = nxt; cA = nA; cB = nB; ++ui;
        if (wr == 1) PG8_BAR;
    }
    PG8_WAIT_V(0);
    PG8_BAR;
#undef PG8_SA
#undef PG8_SB
#undef PG8_STAGE
#undef PG8_LDA
#undef PG8_LDB
#undef PG8_MMA
#undef PG8_WAIT_V
#undef PG8_WAIT_L
#undef PG8_BAR
#undef PG8_SCHED
}

typedef f32x4 Acc[2][2][4][2];
#define GAS __attribute__((address_space(1)))
__device__ __forceinline__ f32x4 ldg4f(const float* p) { return *(const GAS f32x4*)p; }
__device__ __forceinline__ u32x4 ldg4u(const void* p) { return *(const GAS u32x4*)p; }
__device__ __forceinline__ void stg4f(float* p, f32x4 v) { *(GAS f32x4*)p = v; }
__device__ __forceinline__ void stg4u(void* p, u32x4 v) { *(GAS u32x4*)p = v; }
__device__ __forceinline__ f32x4 bfx4_lo(u32x4 w) { return (f32x4){bf_lo(w.x), bf_hi(w.x), bf_lo(w.y), bf_hi(w.y)}; }
__device__ __forceinline__ f32x4 bfx4_hi(u32x4 w) { return (f32x4){bf_lo(w.z), bf_hi(w.z), bf_lo(w.w), bf_hi(w.w)}; }

constexpr int RS_MAX_ORD = 16;
__device__ __forceinline__ void rs_table_fill(LAS float* rsl, int ord, int pm, const float* ssq) {
    int t_ = threadIdx.x; OPAQUE(t_); const int t = t_, r = t >> 1, h = t & 1;
    const float* p = ssq + (size_t)(pm * BM + r) * 16 + h * 8; const f32x4 a = ldg4f(p), b = ldg4f(p + 4);
    float s = ((a[0] + a[1]) + (a[2] + a[3])) + ((b[0] + b[1]) + (b[2] + b[3]));
    s += shx(s, 1, t & 63);
    if (h == 0) rsl[ord * BM + r] = rsqrtf(s * (1.0f / D) + EPS);
}
__device__ __forceinline__ float rs_get(const LAS float* rsl, const float* ssq, int ord, int lrow, int row) { return ord < RS_MAX_ORD ? rsl[ord * BM + lrow] : row_rs(ssq, row); }

struct EpiG1 {
    static constexpr bool HAS_MID = false;
    unsigned char* ws; const float* b_in; const float* ssq; const LAS float* rsl;
    __device__ __forceinline__ void operator()(const Acc& acc, const Unit& u, int wr, int wc, int fr, int fq) const {
        const int lrow0 = wr * 64 + fr, row0 = u.pm * BM + lrow0, cc = wc * 32 + 8 * fq, pn = u.pn;
        float rs[2][4];
#pragma unroll
        for (int ai = 0; ai < 2; ++ai)
#pragma unroll
            for (int m = 0; m < 4; ++m) rs[ai][m] = rs_get(rsl, ssq, u.ord, lrow0 + ai * HALF + m * 16, row0 + ai * HALF + m * 16);
        if (pn < 4 || pn >= 20) {
            bf16_t* dst = (bf16_t*)(ws + (pn < 4 ? WS_PA : WS_CIN)); const int cb = (pn < 4 ? pn : pn - 20) * 256; const float* bs = b_in + (pn < 4 ? 0 : 5120) + cb + cc;
            f32x4 bv[2][2];
#pragma unroll
            for (int bj = 0; bj < 2; ++bj)
#pragma unroll
                for (int n = 0; n < 2; ++n) bv[bj][n] = ldg4f(bs + bj * HALF + 4 * n);
#pragma unroll
            for (int ai = 0; ai < 2; ++ai)
#pragma unroll
                for (int m = 0; m < 4; ++m) { const int row = row0 + ai * HALF + m * 16; const float r = rs[ai][m]; bf16_t* rowp = dst + (size_t)row * D + cb + cc;
#pragma unroll
                    for (int bj = 0; bj < 2; ++bj) stg4u(rowp + bj * HALF, pack8(acc[ai][bj][m][0] * r + bv[bj][0], acc[ai][bj][m][1] * r + bv[bj][1])); }
        } else {
            const bool glu = pn >= 12; const int q = glu ? pn - 12 : pn - 4; const int col = q * 128 + cc;
            bf16_t* dst = (bf16_t*)(ws + (glu ? WS_U : WS_CA)); const float* b0 = b_in + (glu ? 3072 : 1024) + col; const float* b1 = b0 + 1024;
            f32x4 bv[2][2];
#pragma unroll
            for (int n = 0; n < 2; ++n) { bv[0][n] = ldg4f(b0 + 4 * n); bv[1][n] = ldg4f(b1 + 4 * n); }
#pragma unroll
            for (int ai = 0; ai < 2; ++ai)
#pragma unroll
                for (int m = 0; m < 4; ++m) { const int row = row0 + ai * HALF + m * 16; const float r = rs[ai][m];
                    f32x4 p0 = acc[ai][0][m][0] * r + bv[0][0], p1 = acc[ai][0][m][1] * r + bv[0][1], q0 = acc[ai][1][m][0] * r + bv[1][0], q1 = acc[ai][1][m][1] * r + bv[1][1];
                    if (glu) { q0 = sigm4(q0); q1 = sigm4(q1); }
                    stg4u(dst + (size_t)row * D + col, pack8(p0 * q0, p1 * q1)); }
        }
    }
};

typedef unsigned u32x2 __attribute__((ext_vector_type(2)));
__device__ __forceinline__ unsigned pack_q4(f32x4 g) {
    const f32x4 t = g * 255.0f + 0.5f; unsigned w = 0u;
    w = __builtin_amdgcn_cvt_pk_u8_f32(t[0], 0, w); w = __builtin_amdgcn_cvt_pk_u8_f32(t[1], 1, w); w = __builtin_amdgcn_cvt_pk_u8_f32(t[2], 2, w); w = __builtin_amdgcn_cvt_pk_u8_f32(t[3], 3, w); return w;
}
__device__ __forceinline__ f32x4 dec_q4(unsigned w) {
    const f32x4 q = (f32x4){(float)(w & 0xffu), (float)((w >> 8) & 0xffu), (float)((w >> 16) & 0xffu), (float)(w >> 24)};
    return __builtin_elementwise_max(q, (f32x4){0.5f, 0.5f, 0.5f, 0.5f}) * (1.0f / 255.0f);
}
__device__ __forceinline__ f32x4 rcp4(f32x4 v) { return (f32x4){__builtin_amdgcn_rcpf(v[0]), __builtin_amdgcn_rcpf(v[1]), __builtin_amdgcn_rcpf(v[2]), __builtin_amdgcn_rcpf(v[3])}; }
struct EpiG2 {
    static constexpr bool HAS_MID = true;
    unsigned char* ws; const float* bg; const float* bb; const float* scale; const float* ssq; const LAS float* rsl;
    __device__ __forceinline__ void mid(Acc& acc, const Unit& u, int which, int wr, int wc, int fr, int fq) const {
        const int row0 = u.pm * BM + wr * 64 + fr, cc = u.pn * BM + wc * 32 + 8 * fq;
        const size_t base = (size_t)row0 * D + cc;
        const unsigned char* GN = ws + (which == 0 ? WS_GQ0 : WS_GQ1); const unsigned char* GD = ws + (which == 0 ? WS_GQ1 : WS_GQ2);
        f32x4 bv[2][2];
#pragma unroll
        for (int bj = 0; bj < 2; ++bj)
#pragma unroll
            for (int n = 0; n < 2; ++n) bv[bj][n] = which ? ldg4f(bb + cc + bj * HALF + 4 * n) : (f32x4){0.f, 0.f, 0.f, 0.f};
#pragma unroll
        for (int ai = 0; ai < 2; ++ai) {
            u32x2 qn[4][2], qd[4][2];
#pragma unroll
            for (int m = 0; m < 4; ++m)
#pragma unroll
                for (int bj = 0; bj < 2; ++bj) { const size_t off = base + (size_t)(ai * HALF + m * 16) * D + bj * HALF; qn[m][bj] = *(const GAS u32x2*)(GN + off); qd[m][bj] = *(const GAS u32x2*)(GD + off); }
#pragma unroll
            for (int m = 0; m < 4; ++m)
#pragma unroll
                for (int bj = 0; bj < 2; ++bj) {
                    acc[ai][bj][m][0] = (acc[ai][bj][m][0] + bv[bj][0]) * dec_q4(qn[m][bj].x) * rcp4(dec_q4(qd[m][bj].x));
                    acc[ai][bj][m][1] = (acc[ai][bj][m][1] + bv[bj][1]) * dec_q4(qn[m][bj].y) * rcp4(dec_q4(qd[m][bj].y)); }
        }
    }
    __device__ __forceinline__ void operator()(const Acc& acc, const Unit& u, int wr, int wc, int fr, int fq) const {
        const int lrow0 = wr * 64 + fr, row0 = u.pm * BM + lrow0, cc = u.pn * BM + wc * 32 + 8 * fq, kind = u.kind;
        const size_t base = (size_t)row0 * D + cc;
        if (kind < 3) {
            unsigned char* GQ = ws + (kind == 0 ? WS_GQ0 : (kind == 1 ? WS_GQ1 : WS_GQ2));
            const float* b = bg + kind * 1024 + cc;
            f32x4 bv[2][2];
#pragma unroll
            for (int bj = 0; bj < 2; ++bj)
#pragma unroll
                for (int n = 0; n < 2; ++n) bv[bj][n] = ldg4f(b + bj * HALF + 4 * n);
#pragma unroll
            for (int ai = 0; ai < 2; ++ai)
#pragma unroll
                for (int m = 0; m < 4; ++m) { const float r = rs_get(rsl, ssq, u.ord, lrow0 + ai * HALF + m * 16, row0 + ai * HALF + m * 16);
#pragma unroll
                    for (int bj = 0; bj < 2; ++bj) { u32x2 q; q.x = pack_q4(sigm4(acc[ai][bj][m][0] * r + bv[bj][0])); q.y = pack_q4(sigm4(acc[ai][bj][m][1] * r + bv[bj][1]));
                        *(GAS u32x2*)(GQ + base + (size_t)(ai * HALF + m * 16) * D + bj * HALF) = q; } }
        } else {
            const unsigned char* GN = ws + WS_GQ2;
            u32x2 qn[2][4][2];
#pragma unroll
            for (int ai = 0; ai < 2; ++ai)
#pragma unroll
                for (int m = 0; m < 4; ++m)
#pragma unroll
                    for (int bj = 0; bj < 2; ++bj) qn[ai][m][bj] = *(const GAS u32x2*)(GN + base + (size_t)(ai * HALF + m * 16) * D + bj * HALF);
#pragma unroll
            for (int ai = 0; ai < 2; ++ai)
#pragma unroll
                for (int m = 0; m < 4; ++m)
#pragma unroll
                    for (int bj = 0; bj < 2; ++bj) stg4u((bf16_t*)(ws + WS_MRG) + base + (size_t)(ai * HALF + m * 16) * D + bj * HALF,
                        pack8(acc[ai][bj][m][0] * dec_q4(qn[ai][m][bj].x), acc[ai][bj][m][1] * dec_q4(qn[ai][m][bj].y)));
        }
    }
};

struct EpiX {
    static constexpr bool HAS_MID = false;
    bf16_t* XB; float* ssq;
    __device__ __forceinline__ void operator()(const Acc& acc, const Unit& u, int wr, int wc, int fr, int fq) const {
        const int row0 = u.pm * BM + wr * 64 + fr, cc = u.pn * BM + wc * 32 + 8 * fq;
        u32x4 bs[2][4][2];
#pragma unroll
        for (int ai = 0; ai < 2; ++ai)
#pragma unroll
            for (int m = 0; m < 4; ++m)
#pragma unroll
                for (int bj = 0; bj < 2; ++bj) bs[ai][m][bj] = ldg4u(XB + (size_t)(row0 + ai * HALF + m * 16) * D + cc + bj * HALF);
#pragma unroll
        for (int ai = 0; ai < 2; ++ai)
#pragma unroll
            for (int m = 0; m < 4; ++m) { const int row = row0 + ai * HALF + m * 16; float ss = 0.f;
#pragma unroll
                for (int bj = 0; bj < 2; ++bj) { const size_t off = (size_t)row * D + cc + bj * HALF;
                    const f32x4 v0 = bfx4_lo(bs[ai][m][bj]) + acc[ai][bj][m][0], v1 = bfx4_hi(bs[ai][m][bj]) + acc[ai][bj][m][1];
                    stg4u(XB + off, pack8(v0, v1));
                    ss += ((v0[0] * v0[0] + v0[1] * v0[1]) + (v0[2] * v0[2] + v0[3] * v0[3])) + ((v1[0] * v1[0] + v1[1] * v1[1]) + (v1[2] * v1[2] + v1[3] * v1[3])); }
                ss += shx(ss, 16, fq * 16 + (row0 & 15)); ss += shx(ss, 32, fq * 16 + (row0 & 15));
                if (fq == 0) *(GAS float*)(ssq + (size_t)row * 16 + u.pn * 4 + wc) = ss; }
    }
};

struct EpiG4 {
    static constexpr bool HAS_MID = false;
    bf16_t* HID; const float* ssq; const LAS float* rsl;
    __device__ __forceinline__ void operator()(const Acc& acc, const Unit& u, int wr, int wc, int fr, int fq) const {
        const int lrow0 = wr * 64 + fr, row0 = u.pm * BM + lrow0, cc = u.pn * BM + wc * 32 + 8 * fq;
#pragma unroll
        for (int ai = 0; ai < 2; ++ai)
#pragma unroll
            for (int m = 0; m < 4; ++m) { const int row = row0 + ai * HALF + m * 16; const float rs = rs_get(rsl, ssq, u.ord, lrow0 + ai * HALF + m * 16, row);
#pragma unroll
                for (int bj = 0; bj < 2; ++bj) { f32x4 v0 = acc[ai][bj][m][0] * rs, v1 = acc[ai][bj][m][1] * rs;
                    v0 = __builtin_elementwise_max(v0, (f32x4){0.f, 0.f, 0.f, 0.f}); v1 = __builtin_elementwise_max(v1, (f32x4){0.f, 0.f, 0.f, 0.f});
                    stg4u(HID + (size_t)row * FF + cc + bj * HALF, pack8(v0 * v0, v1 * v1)); } }
    }
};
}

__device__ __forceinline__ void tr_item(const float* W, int ldw, const float* gain, bf16_t* WT, int ldd, int k0, int n0, int drow0, LAS float* scr, int lane, const float* ngain = nullptr) {
    float wv[32];
    const float* wp = W + (size_t)(k0 + (lane >> 5)) * ldw + n0 + (lane & 31);
#pragma unroll
    for (int i = 0; i < 32; ++i) wv[i] = __builtin_nontemporal_load((const GAS float*)(wp + (size_t)(2 * i) * ldw));
    float gv0 = 1.0f;
    if (gain) gv0 = gain[k0 + lane];
#pragma unroll
    for (int i = 0; i < 32; ++i) { const int kk = 2 * i + (lane >> 5); const float gv = gain ? __builtin_bit_cast(float, __builtin_amdgcn_ds_bpermute(kk << 2, __builtin_bit_cast(int, gv0))) : 1.0f; scr[kk * 33 + (lane & 31)] = wv[i] * gv; }
    asm volatile("s_waitcnt lgkmcnt(0)" ::: "memory");
    const int c = lane & 7;
#pragma unroll
    for (int j = 0; j < 4; ++j) { const int n = (lane >> 3) + 8 * j; const LAS float* s = scr + (8 * c) * 33 + n; const float ng = ngain ? ngain[n] : 1.0f;
        u32x4 o; o.x = cvt_pk_bf16(s[0 * 33] * ng, s[1 * 33] * ng); o.y = cvt_pk_bf16(s[2 * 33] * ng, s[3 * 33] * ng); o.z = cvt_pk_bf16(s[4 * 33] * ng, s[5 * 33] * ng); o.w = cvt_pk_bf16(s[6 * 33] * ng, s[7 * 33] * ng);
        *(u32x4*)(WT + (size_t)(drow0 + n) * ldd + k0 + 8 * c) = o; }
    asm volatile("s_waitcnt lgkmcnt(0)" ::: "memory");
}
__device__ __forceinline__ int win_row(int n) {
    if (n < 1024 || n >= 5120) return n;
    const int base = n < 3072 ? 1024 : 3072, j = n - base, which = j >> 10, jj = j & 1023;
    return base + (jj >> 7) * 256 + which * 128 + (jj & 127);
}

struct Args { const float* in[19]; float* out; unsigned char* ws; int ph_lo, ph_hi; };

__device__ __forceinline__ f32x2 unpk(unsigned w) { return (f32x2){bf_lo(w), bf_hi(w)}; }
template <int W>
__device__ __forceinline__ void pool_compute(const unsigned (&raw)[47], GAS char* PCg, unsigned ooff, int t0) {
    constexpr int H = W - 1, B0 = 15 - H;
    f32x2 S = (f32x2){0.f, 0.f};
#pragma unroll
    for (int j = 0; j < H; ++j) S += unpk(raw[B0 + j]);
#pragma unroll
    for (int i = 0; i < 32; ++i) {
        const f32x2 v = unpk(raw[15 + i]);
        S += v;
        const float inv = (t0 > 0 || i + 1 >= W) ? (1.0f / W) : (1.0f / (float)(i + 1));
        const f32x2 o = S * inv - v;
        *(GAS unsigned*)(PCg + ooff) = cvt_pk_bf16(o.x, o.y); ooff += D * 2; OPAQUE(ooff);
        S -= unpk(raw[B0 + i]);
    }
}
__device__ __forceinline__ void e_branch_a(GAS char* PAg, const GAS char* CAg, const float* conv_a, unsigned off0, int t0, int c0) {
    {
        unsigned craw[34], braw[32];
        { unsigned off = off0;
#pragma unroll
          for (int j = 0; j < 34; ++j) { craw[j] = *(const GAS unsigned*)(CAg + off); off += D * 2; OPAQUE(off); } }
        { unsigned off = off0;
#pragma unroll
          for (int i = 0; i < 32; ++i) { braw[i] = *(const GAS unsigned*)(PAg + off); off += D * 2; OPAQUE(off); } }
        const f32x2 w0 = *(const GAS f32x2*)(conv_a + c0), w1 = *(const GAS f32x2*)(conv_a + D + c0), w2 = *(const GAS f32x2*)(conv_a + 2 * D + c0);
        if (t0 == 0) { craw[0] = 0u; craw[1] = 0u; }
        unsigned off = off0;
#pragma unroll
        for (int i = 0; i < 32; ++i) {
            const f32x2 z = w0 * unpk(craw[i]) + w1 * unpk(craw[i + 1]) + w2 * unpk(craw[i + 2]);
            const f32x2 o = z * unpk(braw[i]);
            *(GAS unsigned*)(PAg + off) = cvt_pk_bf16(o.x, o.y); off += D * 2; OPAQUE(off);
        }
    }
}
__device__ __forceinline__ void e_branch_c(const GAS char* CINg, GAS char* PCg, unsigned off0, int t0, int wave) {
    {
        unsigned praw[47];
        { unsigned off = off0;
#pragma unroll
          for (int j = 0; j < 47; ++j) { praw[j] = *(const GAS unsigned*)(CINg + off); off += D * 2; OPAQUE(off); } }
        if (t0 == 0) {
#pragma unroll
            for (int j = 0; j < 15; ++j) praw[j] = 0u;
        }
        if (wave < 2) pool_compute<2>(praw, PCg, off0, t0);
        else if (wave < 4) pool_compute<4>(praw, PCg, off0, t0);
        else if (wave < 6) pool_compute<8>(praw, PCg, off0, t0);
        else pool_compute<16>(praw, PCg, off0, t0);
    }
}
__device__ __forceinline__ void e_branch_b_conv(const GAS char* Ug, const f32x2 (&wk)[31], f32x2 cb, LAS f32x2* conv, unsigned off0, int t0, int tid, int ch_lo, int ch_hi) {
#pragma unroll 1
    for (int ch = ch_lo; ch < ch_hi; ++ch) {
        unsigned uraw[38];
        unsigned off = off0 + (unsigned)(ch * 8 * D * 2);
#pragma unroll
        for (int j = 0; j < 38; ++j) { uraw[j] = *(const GAS unsigned*)(Ug + off); off += D * 2; OPAQUE(off); }
        f32x2 uf[38];
#pragma unroll
        for (int j = 0; j < 38; ++j) uf[j] = ((t0 > 0) || (ch * 8 + j - 30 >= 0)) ? unpk(uraw[j]) : (f32x2){0.f, 0.f};
#pragma unroll
        for (int i = 0; i < 8; ++i) { f32x2 acc = cb;
#pragma unroll
            for (int k = 0; k < 31; ++k) acc += wk[k] * uf[i + k];
            conv[(ch * 8 + i) * 512 + tid] = acc; }
    }
}
__device__ __forceinline__ int opaque_idx_e(int k) { asm volatile("" : "+s"(k)); return k; }
__device__ __forceinline__ void e_phase(LAS unsigned char* lds, const Args& a, unsigned char* ws, int l, int G) {
    GAS char* PAg = (GAS char*)(ws + WS_PA); const GAS char* CAg = (const GAS char*)(ws + WS_CA) - 2 * D * 2; const GAS char* Ug = (const GAS char*)(ws + WS_U) - 30 * D * 2;
    const GAS char* CINg = (const GAS char*)(ws + WS_CIN) - 15 * D * 2; GAS char* PCg = (GAS char*)(ws + WS_PC); bf16_t* PB = (bf16_t*)(ws + WS_PB);
    const float* conv_a = a.in[opaque_idx_e(4)] + (size_t)l * 3 * D; const float* conv_b = a.in[opaque_idx_e(6)] + (size_t)l * 31 * D; const float* cbias = a.in[opaque_idx_e(7)] + (size_t)l * D;
    const float* ln_g = a.in[opaque_idx_e(8)] + (size_t)l * D; const float* ln_b = a.in[opaque_idx_e(9)] + (size_t)l * D;
    int tid_ = threadIdx.x; OPAQUE(tid_);
    const int tid = tid_, lane = tid & 63, wave = __builtin_amdgcn_readfirstlane(tid >> 6), c0 = 2 * tid;
    LAS f32x2* conv = (LAS f32x2*)lds;
    f32x2 wk[31];
#pragma unroll
    for (int k = 0; k < 31; ++k) wk[k] = *(const GAS f32x2*)(conv_b + (size_t)k * D + c0);
    const f32x2 cb = *(const GAS f32x2*)(cbias + c0);
    for (int it = blockIdx.x; it < M / 32; it += G) {
        const int m0 = it * 32, t0 = m0 & (SEQ - 1);
        const unsigned off0 = (unsigned)(m0 * D + c0) * 2u;
        if (wave < 4) { e_branch_a(PAg, CAg, conv_a, off0, t0, c0); e_branch_b_conv(Ug, wk, cb, conv, off0, t0, tid, 0, 2); e_branch_c(CINg, PCg, off0, t0, wave); e_branch_b_conv(Ug, wk, cb, conv, off0, t0, tid, 2, 4); }
        else          { e_branch_b_conv(Ug, wk, cb, conv, off0, t0, tid, 0, 2); e_branch_a(PAg, CAg, conv_a, off0, t0, c0); e_branch_b_conv(Ug, wk, cb, conv, off0, t0, tid, 2, 4); e_branch_c(CINg, PCg, off0, t0, wave); }
        __syncthreads();
        {
            f32x4 lg[4], lb[4];
#pragma unroll
            for (int j = 0; j < 4; ++j) { lg[j] = *(const GAS f32x4*)(ln_g + 4 * lane + 256 * j); lb[j] = *(const GAS f32x4*)(ln_b + 4 * lane + 256 * j); }
#pragma unroll 1
            for (int r = 0; r < 4; ++r) { const int row = wave * 4 + r;
                f32x4 v[4]; float s1 = 0.f, s2 = 0.f;
#pragma unroll
                for (int j = 0; j < 4; ++j) { v[j] = *(const LAS f32x4*)((const LAS float*)conv + row * 1024 + 4 * lane + 256 * j);
                    s1 += (v[j][0] + v[j][1]) + (v[j][2] + v[j][3]); s2 += (v[j][0] * v[j][0] + v[j][1] * v[j][1]) + (v[j][2] * v[j][2] + v[j][3] * v[j][3]); }
                s1 = wave_sum(s1, lane); s2 = wave_sum(s2, lane);
                const float mean = s1 * (1.0f / D); float var = s2 * (1.0f / D) - mean * mean; var = var > 0.f ? var : 0.f;
                const float rstd = rsqrtf(var + EPS);
                GAS unsigned long long* o8 = (GAS unsigned long long*)(PB + (size_t)(m0 + row) * D) + lane;
#pragma unroll
                for (int j = 0; j < 4; ++j) { const f32x4 y = (v[j] - mean) * rstd * lg[j] + lb[j];
                    o8[64 * j] = (unsigned long long)cvt_pk_bf16(y[0] * sigm(y[0]), y[1] * sigm(y[1])) | ((unsigned long long)cvt_pk_bf16(y[2] * sigm(y[2]), y[3] * sigm(y[3])) << 32); }
            }
        }
        __syncthreads();
    }
}

#define XB_TMO      128
#define XB_XCNT(j)  (256  + 64 * (j))
#define XB_XSUB(j)  (1280 + 64 * (j))
#define XB_XGEN(j)  (2304 + 64 * (j))
#define XB_TOP      3328
#define XB_TOPGEN   3392
#define XCD_BAR_WORDS 3456
#define XB_SPIN_CAP (1u << 18)
__device__ __forceinline__ unsigned xb_ld(unsigned* p)              { return __hip_atomic_load(p, __ATOMIC_RELAXED, __HIP_MEMORY_SCOPE_AGENT); }
__device__ __forceinline__ unsigned xb_add(unsigned* p, unsigned v) { return __hip_atomic_fetch_add(p, v, __ATOMIC_RELAXED, __HIP_MEMORY_SCOPE_AGENT); }
__device__ __forceinline__ unsigned xb_xcc_id() { return (unsigned)__builtin_amdgcn_s_getreg((3 << 11) | 20) & 0xFu; }
#define XB_SPIN(cond, bar) do { unsigned _sp = 0; while (cond) { __builtin_amdgcn_s_sleep(1); \
    if ((++_sp & 255u) == 0u) { if (xb_ld(&(bar)[XB_TMO])) break; if (_sp > XB_SPIN_CAP) { atomicAdd(&(bar)[XB_TMO], 1u); break; } } } } while (0)
__device__ __forceinline__ void xcd_barrier_complete(unsigned* bar, unsigned x, unsigned& nloc, unsigned& nx) {
    const unsigned G = gridDim.x * gridDim.y * gridDim.z;
    unsigned sum, cnt, mine, sp = 0u;
    for (;;) {
        sum = 0u; cnt = 0u; mine = 0u;
#pragma unroll
        for (unsigned j = 0; j < 16; ++j) { const unsigned c = xb_ld(&bar[XB_XCNT(j)]); sum += c; cnt += (c > 0u) ? 1u : 0u; mine = (j == x) ? c : mine; }
        if (sum == G) break;
        __builtin_amdgcn_s_sleep(1);
        if ((++sp & 255u) == 0u) { if (xb_ld(&bar[XB_TMO])) break; if (sp > XB_SPIN_CAP) { atomicAdd(&bar[XB_TMO], 1u); break; } }
    }
    nloc = mine > 0u ? mine : 1u; nx = cnt > 0u ? cnt : 1u;
}
__device__ __forceinline__ void xcd_barrier(unsigned* bar, volatile LAS unsigned* st) {
    asm volatile("s_waitcnt vmcnt(0)" ::: "memory");
    __syncthreads();
    if (threadIdx.x == 0) {
        __builtin_amdgcn_s_waitcnt(0);
        const unsigned x = xb_xcc_id();
        unsigned nloc = st[0], nx = st[1];
        if (nloc == 0u) { xcd_barrier_complete(bar, x, nloc, nx); st[0] = nloc; st[1] = nx; }
        const unsigned old = xb_add(&bar[XB_XSUB(x)], 1u);
        const unsigned gen = old / nloc;
        if (old + 1u == (gen + 1u) * nloc) {
            __builtin_amdgcn_fence(__ATOMIC_RELEASE, "agent");
            asm volatile("s_waitcnt vmcnt(0)" ::: "memory");
            const unsigned og = xb_add(&bar[XB_TOP], 1u);
            const unsigned tg = og / nx;
            if (og + 1u == (tg + 1u) * nx) xb_add(&bar[XB_TOPGEN], 1u);
            else XB_SPIN(xb_ld(&bar[XB_TOPGEN]) == tg, bar);
            __builtin_amdgcn_fence(__ATOMIC_ACQUIRE, "agent");
            xb_add(&bar[XB_XGEN(x)], 1u);
            asm volatile("s_waitcnt vmcnt(0)" ::: "memory");
        } else {
            XB_SPIN(xb_ld(&bar[XB_XGEN(x)]) == gen, bar);
            __builtin_amdgcn_fence(__ATOMIC_ACQUIRE, "agent");
            asm volatile("s_waitcnt vmcnt(0)" ::: "memory");
        }
    }
    __syncthreads();
}

#define LAUNDER_S(p) asm volatile("" : "+s"(p))
__device__ __forceinline__ int opaque_idx(int k) { asm volatile("" : "+s"(k)); return k; }
#define AIN(k) (a.in[opaque_idx(k)])
__global__ void __launch_bounds__(512, 2) mk_fwd(Args a) {
    __shared__ __attribute__((aligned(16))) unsigned char lds_raw[LDS_BYTES];
    LAS unsigned char* lds = (LAS unsigned char*)lds_raw;
    volatile LAS unsigned* bst = (volatile LAS unsigned*)(lds + MISC_OFF);
    if (threadIdx.x < 2) bst[threadIdx.x] = 0u;
    __syncthreads();
    if (a.ph_hi - a.ph_lo > 1 && threadIdx.x == 0) (void)xb_add((unsigned*)a.ws + XB_XCNT(xb_xcc_id()), 1u);
#ifndef PROBE_REPS
#define PROBE_REPS 0
#define PROBE_PHASE 0
#endif
    const int hi = a.ph_hi + PROBE_REPS;
#pragma unroll 1
    for (int q = a.ph_lo; q < hi; ++q) {
        const bool probe = PROBE_REPS > 0 && q >= NPH;
        const int p = probe ? PROBE_PHASE : q;
        const int l = p / 7, k = p - 7 * l;
        int G = gridDim.x, bx = blockIdx.x; LAUNDER_S(G); LAUNDER_S(bx);
        unsigned char* ws = a.ws; LAUNDER_S(ws);
        float* SSQ = (float*)(ws + WS_SSQ);
        if (p == 7 * DEPTH) {
            if (PH_MASK & 128) {
                int tid_ = threadIdx.x; OPAQUE(tid_);
                const int lane = tid_ & 63, gw = bx * 8 + (tid_ >> 6), NGW = G * 8;
                const float* gf = AIN(18); const bf16_t* XB = (const bf16_t*)(ws + WS_XB);
                f32x4 g4[2][2];
#pragma unroll
                for (int j = 0; j < 2; ++j) { g4[j][0] = *(const GAS f32x4*)(gf + 8 * lane + 512 * j); g4[j][1] = *(const GAS f32x4*)(gf + 8 * lane + 512 * j + 4); }
                for (int m = gw; m < M; m += NGW) {
                    const u32x4 w0 = *(const GAS u32x4*)(XB + (size_t)m * D + 8 * lane), w1 = *(const GAS u32x4*)(XB + (size_t)m * D + 8 * lane + 512);
                    const float rs = row_rs(SSQ, m);
                    float* o = a.out + (size_t)m * D + 8 * lane;
                    *(GAS f32x4*)(o) = pg8::bfx4_lo(w0) * rs * g4[0][0]; *(GAS f32x4*)(o + 4) = pg8::bfx4_hi(w0) * rs * g4[0][1];
                    *(GAS f32x4*)(o + 512) = pg8::bfx4_lo(w1) * rs * g4[1][0]; *(GAS f32x4*)(o + 516) = pg8::bfx4_hi(w1) * rs * g4[1][1];
                }
            }
        } else if (k == 0) {
            if (PH_MASK & 1) {
                int tid_ = threadIdx.x; OPAQUE(tid_);
                const int lane = tid_ & 63, wave = __builtin_amdgcn_readfirstlane(tid_ >> 6), gw = bx * 8 + wave, NGW = G * 8;
                bf16_t* WIN = (bf16_t*)(ws + WS_WIN); bf16_t* WA = (bf16_t*)(ws + WS_WA); bf16_t* WB = (bf16_t*)(ws + WS_WB); bf16_t* WP = (bf16_t*)(ws + WS_WP);
                bf16_t* WO = (bf16_t*)(ws + WS_WO); bf16_t* W1 = (bf16_t*)(ws + WS_W1); bf16_t* W2 = (bf16_t*)(ws + ((l & 1) ? WS_W2B : WS_W2)); bf16_t* XB = (bf16_t*)(ws + WS_XB);
                LAS float* scr = (LAS float*)(lds + wave * 16384);
                const float* g_mix = AIN(1) + (size_t)l * D; const float* w_in = AIN(2) + (size_t)l * D * PIN;
                const float* w_a = AIN(5) + (size_t)l * D * D; const float* w_b = AIN(10) + (size_t)l * D * D; const float* w_p = AIN(12) + (size_t)l * 4 * 65536;
                const float* w_o = AIN(14) + (size_t)l * D * D; const float* g_mlp = AIN(15) + (size_t)l * D; const float* w_1 = AIN(16) + (size_t)l * D * FF; const float* w_2 = AIN(17) + (size_t)l * FF * D;
                constexpr int I_IN = 16 * 288, I_SQ = 16 * 32, I_P = 128, I_1 = 16 * 128, I_2 = 64 * 32, NITEMS = I_IN + 3 * I_SQ + I_P + I_1 + I_2;
                for (int it = gw; it < NITEMS; it += NGW) {
                    int r = it;
                    if (r < I_IN) { const int kb = r / 288, nb = r - kb * 288; tr_item(w_in, PIN, g_mix, WIN, D, kb * 64, nb * 32, win_row(nb * 32), scr, lane); continue; } r -= I_IN;
                    if (r < I_SQ) { tr_item(w_a, D, nullptr, WA, D, (r >> 5) * 64, (r & 31) * 32, (r & 31) * 32, scr, lane); continue; } r -= I_SQ;
                    if (r < I_SQ) { tr_item(w_b, D, nullptr, WB, D, (r >> 5) * 64, (r & 31) * 32, (r & 31) * 32, scr, lane); continue; } r -= I_SQ;
                    if (r < I_SQ) { tr_item(w_o, D, nullptr, WO, D, (r >> 5) * 64, (r & 31) * 32, (r & 31) * 32, scr, lane); continue; } r -= I_SQ;
                    if (r < I_P) { const int gi = r >> 5, kb = (r & 31) >> 3, nb = r & 7; tr_item(w_p + (size_t)gi * 65536, 256, nullptr, WP, D, kb * 64, nb * 32, gi * 256 + nb * 32, scr, lane, AIN(13) + (size_t)l * D + gi * 256 + nb * 32); continue; } r -= I_P;
                    if (r < I_1) { const int kb = r >> 7, nb = r & 127; tr_item(w_1, FF, g_mlp, W1, D, kb * 64, nb * 32, nb * 32, scr, lane); continue; } r -= I_1;
                    { const int kb = r >> 5, nb = r & 31; tr_item(w_2, D, nullptr, W2, FF, kb * 64, nb * 32, nb * 32, scr, lane); }
                }
                if (l == 0) {
                    const float* x = AIN(0);
                    for (int m = gw; m < M; m += NGW) {
                        const f32x4* xr = (const f32x4*)(x + (size_t)m * D) + lane; f32x4 v[4]; float s = 0.f;
#pragma unroll
                        for (int j = 0; j < 4; ++j) { v[j] = __builtin_nontemporal_load((const GAS f32x4*)xr + 64 * j); s += (v[j][0] * v[j][0] + v[j][1] * v[j][1]) + (v[j][2] * v[j][2] + v[j][3] * v[j][3]); }
                        s = wave_sum(s, lane);
                        unsigned long long* o8 = (unsigned long long*)(XB + (size_t)m * D) + lane;
#pragma unroll
                        for (int j = 0; j < 4; ++j) o8[64 * j] = (unsigned long long)cvt_pk_bf16(v[j][0], v[j][1]) | ((unsigned long long)cvt_pk_bf16(v[j][2], v[j][3]) << 32);
                        if (lane < 16) SSQ[(size_t)m * 16 + lane] = lane == 0 ? s : 0.f;
                    }
                }
                __syncthreads();
            }
        } else if (k == 1) {
            if (PH_MASK & 2) {
                pg8::SchedPlain S; S.T.init(M, 6144, G, bx); S.A = (const char*)(ws + WS_XB); S.B = (const char*)(ws + WS_WIN); S.atile = (size_t)256 * D * 2; S.btile = (size_t)256 * D * 2; S.nt = D / 64;
                LAS float* rsl = (LAS float*)(lds + RING_BYTES);
                { pg8::Unit t; for (int j = 0; j < pg8::RS_MAX_ORD && S.next(j, t); ++j) pg8::rs_table_fill(rsl, j, t.pm, SSQ); }
                __syncthreads();
                pg8::EpiG1 E{ws, AIN(3) + (size_t)l * PIN, SSQ, rsl};
                pg8::gemm_phase(lds, pg8::Gemm{D, D}, S, E);
            }
        } else if (k == 2) {
            if (PH_MASK & 4) e_phase(lds, a, ws, l, G);
        } else if (k == 3) {
            if (PH_MASK & 8) {
                pg8::SchedG2 S; S.T.init(M, D, G, bx); S.ws = (const char*)ws;
                LAS float* rsl = (LAS float*)(lds + RING_BYTES);
                { int pm, pn; for (int j = 0; j < pg8::RS_MAX_ORD && S.T.tile(j, pm, pn); ++j) pg8::rs_table_fill(rsl, j, pm, SSQ); }
                __syncthreads();
                pg8::EpiG2 E{ws, AIN(3) + (size_t)l * PIN + 6144, AIN(11) + (size_t)l * D, AIN(13) + (size_t)l * D, SSQ, rsl};
                pg8::gemm_phase(lds, pg8::Gemm{D, D}, S, E);
            }
        } else if (k == 4) {
            if (PH_MASK & 16) {
                pg8::SchedPlain S; S.T.init(M, D, G, bx); S.A = (const char*)(ws + WS_MRG); S.B = (const char*)(ws + WS_WO); S.atile = (size_t)256 * D * 2; S.btile = (size_t)256 * D * 2; S.nt = D / 64;
                pg8::EpiX E{(bf16_t*)(ws + (probe ? WS_PB : WS_XB)), SSQ};
                pg8::gemm_phase(lds, pg8::Gemm{D, D}, S, E);
            }
        } else if (k == 5) {
            if (PH_MASK & 32) {
                pg8::SchedPlain S; S.T.init(M, FF, G, bx); S.A = (const char*)(ws + WS_XB); S.B = (const char*)(ws + WS_W1); S.atile = (size_t)256 * D * 2; S.btile = (size_t)256 * D * 2; S.nt = D / 64;
                LAS float* rsl = (LAS float*)(lds + RING_BYTES);
                { pg8::Unit t; for (int j = 0; j < pg8::RS_MAX_ORD && S.next(j, t); ++j) pg8::rs_table_fill(rsl, j, t.pm, SSQ); }
                __syncthreads();
                pg8::EpiG4 E{(bf16_t*)(ws + WS_HID), SSQ, rsl};
                pg8::gemm_phase(lds, pg8::Gemm{D, D}, S, E);
            }
        } else {
            if (PH_MASK & 64) {
                pg8::SchedPlain S; S.T.init(M, D, G, bx); S.A = (const char*)(ws + WS_HID); S.B = (const char*)(ws + ((l & 1) ? WS_W2B : WS_W2)); S.atile = (size_t)256 * FF * 2; S.btile = (size_t)256 * FF * 2; S.nt = FF / 64;
                pg8::EpiX E{(bf16_t*)(ws + (probe ? WS_PB : WS_XB)), SSQ};
                pg8::gemm_phase(lds, pg8::Gemm{FF, FF}, S, E);
            }
        }
        const bool seam_free = !probe && k == 6 && q + 1 < NPH && (q + 1) < 7 * DEPTH;
        if (q + 1 < hi && !seam_free) { if (a.ph_lo < 0) cg::this_grid().sync(); else xcd_barrier((unsigned*)a.ws, bst); }
    }
}


#ifdef DUMP_AFTER
__global__ void dump_k(const unsigned char* ws, float* out, int which) {
    const size_t n = (size_t)M * D; const bf16_t* b0 = (const bf16_t*)(ws + WS_PA); const bf16_t* b1 = (const bf16_t*)(ws + WS_PB); const bf16_t* b2 = (const bf16_t*)(ws + WS_PC);
    const bf16_t* sc = (const bf16_t*)(ws + WS_MRG); const bf16_t* xb = (const bf16_t*)(ws + WS_XB);
    for (size_t i = blockIdx.x * (size_t)blockDim.x + threadIdx.x; i < n; i += (size_t)gridDim.x * blockDim.x) {
        float v;
        if (which == 1) v = __uint_as_float((unsigned)b0[i] << 16) + 2.f * __uint_as_float((unsigned)((const bf16_t*)(ws + WS_CA))[i] << 16) + 4.f * __uint_as_float((unsigned)((const bf16_t*)(ws + WS_U))[i] << 16) + 8.f * __uint_as_float((unsigned)((const bf16_t*)(ws + WS_CIN))[i] << 16);
        else if (which == 2) v = __uint_as_float((unsigned)b0[i] << 16) + 2.f * __uint_as_float((unsigned)b1[i] << 16) + 4.f * __uint_as_float((unsigned)b2[i] << 16);
        else if (which == 3) v = __uint_as_float((unsigned)sc[i] << 16);
        else v = __uint_as_float((unsigned)xb[i] << 16);
        out[i] = v;
    }
}
#endif
extern "C" void kernel_launch(void* const* d_in, const int* in_sizes, int n_in, void* d_out, int out_size, void* d_ws, size_t ws_size, hipStream_t stream) {
    static int grid = 0;
    if (grid == 0) {
        if (n_in != 19 || in_sizes[0] != M * D || out_size != M * D || ws_size < WS_END) { fprintf(stderr, "kernel_launch: unexpected shapes (n_in %d, in0 %d, out %d, ws %zu)\n", n_in, n_in > 0 ? in_sizes[0] : -1, out_size, ws_size); grid = -1; return; }
        int dev = 0, cus = 0, per_cu = 0;
        if (hipGetDevice(&dev) != hipSuccess || hipDeviceGetAttribute(&cus, hipDeviceAttributeMultiprocessorCount, dev) != hipSuccess) { grid = -1; return; }
        if (hipOccupancyMaxActiveBlocksPerMultiprocessor(&per_cu, (const void*)mk_fwd, 512, 0) != hipSuccess || per_cu < 1) { fprintf(stderr, "kernel_launch: occupancy query says %d\n", per_cu); per_cu = 1; }
        (void)hipGetLastError();
        grid = cus * 1;
    }
    if (grid < 0) return;
    Args a{};
    for (int i = 0; i < 19; ++i) a.in[i] = (const float*)d_in[i];
    a.out = (float*)d_out; a.ws = (unsigned char*)d_ws;
#if MK_N_LAUNCHES == 1
    if (hipMemsetAsync(d_ws, 0, 16384, stream) != hipSuccess) { fprintf(stderr, "kernel_launch: memset of the barrier words failed\n"); return; }
    a.ph_lo = 0; a.ph_hi = NPH;
    void* args[] = {&a};
    hipError_t e = hipLaunchCooperativeKernel((const void*)mk_fwd, dim3(grid), dim3(512), args, 0, stream);
    if (e != hipSuccess) fprintf(stderr, "kernel_launch: cooperative launch failed: %s (grid %d)\n", hipGetErrorString(e), grid);
#else
#ifdef DUMP_AFTER
    for (int p = 0; p <= DUMP_AFTER; ++p) { a.ph_lo = p; a.ph_hi = p + 1; hipLaunchKernelGGL(mk_fwd, dim3(grid), dim3(512), 0, stream, a); }
    hipLaunchKernelGGL(dump_k, dim3(2048), dim3(256), 0, stream, (const unsigned char*)d_ws, (float*)d_out, (int)DUMP_AFTER);
#else
    for (int p = 0; p < NPH; ++p) { a.ph_lo = p; a.ph_hi = p + 1; hipLaunchKernelGGL(mk_fwd, dim3(grid), dim3(512), 0, stream, a); }
#endif
#endif
}
```
